# Optimizing an MI355X kernel written in HIP

```python
import math
import jax, jax.numpy as jnp
from jax import lax
import numpy as np

D_MODEL = 1024
BATCH = 4
SEQ = 4096
DEPTH = 2

CTX_LEN = 256
GRID_W = 64
HEAD_DIM = 64
MIX_HEADS = D_MODEL // HEAD_DIM
BLOCK = 128
WINDOW = 128
ROPE_THETA = 10000.0
LN_EPS = 1e-6
RMS_EPS = 1e-6
NEG_INF = -1e30
N_MOD = 6

A_GROUPS = MIX_HEADS // 4
A_W = A_GROUPS * HEAD_DIM
B_Q_HEADS = MIX_HEADS - A_GROUPS
B_KV_HEADS = B_Q_HEADS // 3
B_GROUP = B_Q_HEADS // B_KV_HEADS
AB_Q_W = A_W + B_Q_HEADS * HEAD_DIM
AB_KV_W = 2 * B_KV_HEADS * HEAD_DIM
AB_IN_W = AB_Q_W + AB_KV_W
AB_OUT_W = A_W + B_Q_HEADS * HEAD_DIM

C_HEADS = MIX_HEADS // 4
D_Q_HEADS = MIX_HEADS // 2
D_KV_HEADS = D_Q_HEADS // 4
D_GROUP = D_Q_HEADS // D_KV_HEADS
C_QK_W = C_HEADS * 2 * HEAD_DIM
D_Q_W = D_Q_HEADS * HEAD_DIM
D_KV_W = D_KV_HEADS * HEAD_DIM
C_V_W = C_HEADS * 2 * HEAD_DIM
CD_Q_W = C_QK_W + D_Q_W
CD_KV_W = C_QK_W + D_KV_W + C_V_W + D_KV_W
CD_IN_W = CD_Q_W + CD_KV_W
CD_OUT_W = C_V_W + D_Q_W

N_EXPERTS = 32
TOP_K = 4
EXPERT_FF = D_MODEL
SWIGLU_LIMIT = 7.0
SWIGLU_ALPHA = 1.702
MOE_BLOCK = 128

DEEPNORM_ALPHA = (2 * DEPTH) ** 0.25
DEEPNORM_BETA = (8 * DEPTH) ** -0.25
N_EVEN = (DEPTH + 1) // 2
N_ODD = DEPTH // 2

kernel_name = 'hybrid_fourier_window_diff_axial_moe_dit'


def _layernorm(x, g, b):
    xf = x.astype(jnp.float32)
    mu = jnp.mean(xf, axis=-1, keepdims=True)
    var = jnp.mean(jnp.square(xf - mu), axis=-1, keepdims=True)
    return ((xf - mu) * lax.rsqrt(var + LN_EPS) * g + b).astype(x.dtype)


def _rmsnorm(x, g):
    xf = x.astype(jnp.float32)
    y = xf * lax.rsqrt(jnp.mean(jnp.square(xf), axis=-1, keepdims=True) + RMS_EPS)
    return (y * g).astype(x.dtype)


def _post_norm(x, y, gate, g, b):
    return _layernorm(DEEPNORM_ALPHA * x + gate * y, g, b)


def _modulate(x, shift, scale):
    return x * (1 + scale) + shift


def _axial_rope_tables(rows, d):
    t = jnp.arange(rows * GRID_W)
    row = (t // GRID_W).astype(jnp.float32)
    col = (t % GRID_W).astype(jnp.float32)
    nf = d // 4
    inv = ROPE_THETA ** (-jnp.arange(nf, dtype=jnp.float32) / nf)
    ar = row[:, None] * inv[None, :]
    ac = col[:, None] * inv[None, :]
    ang = jnp.concatenate([ar, ar, ac, ac], axis=-1)
    return jnp.cos(ang), jnp.sin(ang)


def _apply_rope(x, cos, sin):
    d = x.shape[-1]
    nf = d // 4
    shp = (cos.shape[0],) + (1,) * (x.ndim - 3) + (d,)
    cs, sn = cos.reshape(shp), sin.reshape(shp)
    xf = x.astype(jnp.float32)
    rot = jnp.concatenate([-xf[..., nf:2 * nf], xf[..., :nf], -xf[..., 3 * nf:], xf[..., 2 * nf:3 * nf]], axis=-1)
    return (xf * cs + rot * sn).astype(x.dtype)


def _gqa_scores(q, k):
    return jnp.einsum('bqhgd,bkhd->bhgqk', q, k).astype(jnp.float32) * (q.shape[-1] ** -0.5)


def _gqa_apply(p, v):
    return jnp.einsum('bhgqk,bkhd->bqhgd', p.astype(v.dtype), v)


def _gqa_attention(q, k, v):
    return _gqa_apply(jax.nn.softmax(_gqa_scores(q, k), axis=-1), v)


def _sink_attention(q, k, v, sink):
    s = _gqa_scores(q, k)
    s_sink = jnp.broadcast_to(sink.reshape(B_KV_HEADS, B_GROUP).astype(jnp.float32)[None, :, :, None, None], s.shape[:-1] + (1,))
    p = jax.nn.softmax(jnp.concatenate([s, s_sink], axis=-1), axis=-1)
    return _gqa_apply(p[..., :-1], v)


def _window_attention(q, k, v, kc, vc, sink):
    B, S, Hkv, G, d = q.shape
    n_ctx = kc.shape[1]
    pad = ((0, 0), (BLOCK, BLOCK), (0, 0), (0, 0))
    kp, vp = jnp.pad(k, pad), jnp.pad(v, pad)
    sink_hg = sink.reshape(Hkv, G).astype(jnp.float32)[None, :, :, None, None]
    offs_q = jnp.arange(BLOCK)
    offs_k = jnp.arange(3 * BLOCK) - BLOCK

    def block(n):
        q0 = n * BLOCK
        qb = lax.dynamic_slice_in_dim(q, q0, BLOCK, axis=1)
        kb = lax.dynamic_slice_in_dim(kp, q0, 3 * BLOCK, axis=1)
        vb = lax.dynamic_slice_in_dim(vp, q0, 3 * BLOCK, axis=1)
        qpos = q0 + offs_q
        kpos = q0 + offs_k
        allowed = (jnp.abs(qpos[:, None] - kpos[None, :]) <= WINDOW) & (kpos >= 0)[None, :] & (kpos < S)[None, :]
        s_loc = jnp.where(allowed, _gqa_scores(qb, kb), NEG_INF)
        s_ctx = _gqa_scores(qb, kc)
        s_sink = jnp.broadcast_to(sink_hg, s_ctx.shape[:-1] + (1,))
        p = jax.nn.softmax(jnp.concatenate([s_loc, s_ctx, s_sink], axis=-1), axis=-1)
        return _gqa_apply(p[..., :3 * BLOCK], vb) + _gqa_apply(p[..., 3 * BLOCK:3 * BLOCK + n_ctx], vc)

    o = lax.map(block, jnp.arange(S // BLOCK))
    return jnp.moveaxis(o, 0, 1).reshape(B, S, Hkv * G * d)


def _fourier_mix(a):
    B, T, _ = a.shape
    g = a.reshape(B, T, A_GROUPS, HEAD_DIM).astype(jnp.float32)
    f = jnp.fft.fft2(g, axes=(1, 3), norm='ortho').real
    return f.reshape(B, T, A_W).astype(a.dtype)


def _ab_mixer(h_lat, h_ctx, w_in, sink, w_out, cos, sin, need_ctx_out):
    B, S, _ = h_lat.shape
    n_ctx = h_ctx.shape[1]
    p_lat = h_lat @ w_in
    kv_ctx = h_ctx @ w_in[:, AB_Q_W:]

    def kv_split(kv, T):
        k = kv[..., :AB_KV_W // 2].reshape(B, T, B_KV_HEADS, HEAD_DIM)
        v = kv[..., AB_KV_W // 2:].reshape(B, T, B_KV_HEADS, HEAD_DIM)
        return k, v

    k_lat, v_lat = kv_split(p_lat[..., AB_Q_W:], S)
    k_ctx, v_ctx = kv_split(kv_ctx, n_ctx)
    k_lat = _apply_rope(k_lat, cos, sin)
    q_lat = _apply_rope(p_lat[..., A_W:AB_Q_W].reshape(B, S, B_KV_HEADS, B_GROUP, HEAD_DIM), cos, sin)
    o_lat = jnp.concatenate([_fourier_mix(p_lat[..., :A_W]),
                             _window_attention(q_lat, k_lat, v_lat, k_ctx, v_ctx, sink)], axis=-1)
    y_lat = o_lat @ w_out
    y_ctx = None
    if need_ctx_out:
        qs_ctx = h_ctx @ w_in[:, :AB_Q_W]
        q_ctx = qs_ctx[..., A_W:].reshape(B, n_ctx, B_KV_HEADS, B_GROUP, HEAD_DIM)
        o_ctx = jnp.concatenate([_fourier_mix(qs_ctx[..., :A_W]),
                                 _sink_attention(q_ctx, k_ctx, v_ctx, sink).reshape(B, n_ctx, B_Q_HEADS * HEAD_DIM)], axis=-1)
        y_ctx = o_ctx @ w_out
    return y_lat, y_ctx


def _split_cd_q(qs):
    B, T, _ = qs.shape
    q_c = qs[..., :C_QK_W].reshape(B, T, C_HEADS, 2, HEAD_DIM)
    q_d = qs[..., C_QK_W:].reshape(B, T, D_KV_HEADS, D_GROUP, HEAD_DIM)
    return q_c, q_d


def _split_cd_kv(kv):
    B, T, _ = kv.shape
    o1 = C_QK_W
    o2 = o1 + D_KV_W
    o3 = o2 + C_V_W
    k_c = kv[..., :o1].reshape(B, T, C_HEADS, 2, HEAD_DIM)
    k_d = kv[..., o1:o2].reshape(B, T, D_KV_HEADS, HEAD_DIM)
    v_c = kv[..., o2:o3].reshape(B, T, C_HEADS, 2 * HEAD_DIM)
    v_d = kv[..., o3:].reshape(B, T, D_KV_HEADS, HEAD_DIM)
    return k_c, k_d, v_c, v_d


def _diff_attention(q, k, v, lam, subln_g, lambda_init):
    s = jnp.einsum('bqhmd,bkhmd->bhmqk', q, k).astype(jnp.float32) * (HEAD_DIM ** -0.5)
    p = jax.nn.softmax(s, axis=-1)
    w = p[:, :, 0] - lam * p[:, :, 1]
    o = jnp.einsum('bhqk,bkhd->bqhd', w.astype(v.dtype), v)
    return _rmsnorm(o, subln_g) * (1.0 - lambda_init)


def _lambda_init(layer):
    return 0.8 - 0.6 * math.exp(-0.3 * layer)


def _cd_mixer(h_lat, h_ctx, w_in, lam_vec, subln_g, q_norm_g, k_norm_g, w_out, lambda_init, cos, sin, need_ctx_out):
    B, S, _ = h_lat.shape
    n_ctx = h_ctx.shape[1]
    lv = lam_vec.astype(jnp.float32)
    lam = jnp.exp(jnp.sum(lv[0] * lv[1])) - jnp.exp(jnp.sum(lv[2] * lv[3])) + lambda_init
    p_lat = h_lat @ w_in
    q_c, q_d = _split_cd_q(p_lat[..., :CD_Q_W])
    k_c, k_d, v_c, v_d = _split_cd_kv(p_lat[..., CD_Q_W:])
    k_c_ctx, k_d_ctx, v_c_ctx, v_d_ctx = _split_cd_kv(h_ctx @ w_in[:, CD_Q_W:])
    q_c = _apply_rope(q_c, cos, sin)
    k_c = _apply_rope(k_c, cos, sin)
    q_d = _apply_rope(_rmsnorm(q_d, q_norm_g), cos, sin)
    k_d = _apply_rope(_rmsnorm(k_d, k_norm_g), cos, sin)
    k_d_ctx = _rmsnorm(k_d_ctx, k_norm_g)
    k_c_all = jnp.concatenate([k_c_ctx, k_c], axis=1)
    v_c_all = jnp.concatenate([v_c_ctx, v_c], axis=1)
    k_d_all = jnp.concatenate([k_d_ctx, k_d], axis=1)
    v_d_all = jnp.concatenate([v_d_ctx, v_d], axis=1)

    def block(n):
        q0 = n * BLOCK
        qcb = lax.dynamic_slice_in_dim(q_c, q0, BLOCK, axis=1)
        qdb = lax.dynamic_slice_in_dim(q_d, q0, BLOCK, axis=1)
        oc = _diff_attention(qcb, k_c_all, v_c_all, lam, subln_g, lambda_init)
        od = _gqa_attention(qdb, k_d_all, v_d_all)
        return jnp.concatenate([oc.reshape(B, BLOCK, C_V_W), od.reshape(B, BLOCK, D_Q_W)], axis=-1)

    o = lax.map(block, jnp.arange(S // BLOCK))
    y_lat = jnp.moveaxis(o, 0, 1).reshape(B, S, CD_OUT_W) @ w_out
    y_ctx = None
    if need_ctx_out:
        q_c_ctx, q_d_ctx = _split_cd_q(h_ctx @ w_in[:, :CD_Q_W])
        q_d_ctx = _rmsnorm(q_d_ctx, q_norm_g)
        o_ctx = jnp.concatenate([
            _diff_attention(q_c_ctx, k_c_ctx, v_c_ctx, lam, subln_g, lambda_init).reshape(B, n_ctx, C_V_W),
            _gqa_attention(q_d_ctx, k_d_ctx, v_d_ctx).reshape(B, n_ctx, D_Q_W)], axis=-1)
        y_ctx = o_ctx @ w_out
    return y_lat, y_ctx


def _moe(h, router_w, router_b, w_gu, b_gu, w_down, b_down):
    n_tok, d = h.shape
    logits = (h @ router_w + router_b).astype(jnp.float32)
    top_logit, top_e = lax.top_k(logits, TOP_K)
    gates = jax.nn.softmax(top_logit, axis=-1)
    n_asg = n_tok * TOP_K
    flat_e = top_e.reshape(n_asg)
    order = jnp.argsort(flat_e)
    sorted_e = flat_e[order]
    counts = jnp.bincount(flat_e, length=N_EXPERTS)
    padded = (counts + MOE_BLOCK - 1) // MOE_BLOCK * MOE_BLOCK
    start = jnp.cumsum(counts) - counts
    pend = jnp.cumsum(padded)
    pstart = pend - padded
    dest = (pstart[sorted_e] + jnp.arange(n_asg) - start[sorted_e]).astype(jnp.int32)
    n_blocks = -(-n_asg // MOE_BLOCK) + N_EXPERTS
    buf_tok = jnp.full((n_blocks * MOE_BLOCK,), n_tok, jnp.int32).at[dest].set((order // TOP_K).astype(jnp.int32))
    block_e = jnp.minimum(jnp.searchsorted(pend, jnp.arange(n_blocks) * MOE_BLOCK, side='right'), N_EXPERTS - 1)
    xb = jnp.concatenate([h, jnp.zeros((1, d), h.dtype)], axis=0)[buf_tok].reshape(n_blocks, MOE_BLOCK, d)

    def expert_block(args):
        xblk, e = args
        gu = xblk @ w_gu[e] + b_gu[e]
        g = jnp.minimum(gu[..., :EXPERT_FF], SWIGLU_LIMIT)
        u = jnp.clip(gu[..., EXPERT_FF:], -SWIGLU_LIMIT, SWIGLU_LIMIT)
        return ((u + 1.0) * (g * jax.nn.sigmoid(SWIGLU_ALPHA * g))) @ w_down[e] + b_down[e]

    yb = lax.map(expert_block, (xb, block_e)).reshape(n_blocks * MOE_BLOCK, d)
    slot = jnp.zeros((n_asg,), jnp.int32).at[order].set(dest)
    y = yb[slot].reshape(n_tok, TOP_K, d)
    return jnp.einsum('nk,nkd->nd', gates.astype(y.dtype), y)


def setup_inputs(seed: int = 0) -> dict:
    key = jax.random.key(seed)
    ks = jax.random.split(key, 23)
    f32 = jnp.float32
    D = D_MODEL

    def nrm(k, shape, scale):
        return jax.random.normal(k, shape, f32) * scale

    return {
        'x': nrm(ks[0], (BATCH, SEQ, D), 1.0),
        'c': nrm(ks[1], (BATCH, D), 1.0),
        'ctx': nrm(ks[2], (BATCH, CTX_LEN, D), 1.0),
        'c_ctx': nrm(ks[3], (D,), 1.0),
        'mod_w': nrm(ks[4], (DEPTH, D, N_MOD * D), 0.5 * D ** -0.5),
        'mod_b': nrm(ks[5], (DEPTH, N_MOD * D), 0.02),
        'ln_g': 1.0 + nrm(ks[6], (DEPTH, 2, D), 0.02),
        'ln_b': nrm(ks[7], (DEPTH, 2, D), 0.02),
        'ab_w_in': nrm(ks[8], (N_EVEN, D, AB_IN_W), D ** -0.5),
        'ab_sink': nrm(ks[9], (N_EVEN, B_Q_HEADS), 0.5),
        'ab_w_out': nrm(ks[10], (N_EVEN, AB_OUT_W, D), DEEPNORM_BETA * AB_OUT_W ** -0.5),
        'cd_w_in': nrm(ks[11], (N_ODD, D, CD_IN_W), D ** -0.5),
        'cd_lambda': nrm(ks[12], (N_ODD, 4, HEAD_DIM), 0.1),
        'cd_subln_g': 1.0 + nrm(ks[13], (N_ODD, 2 * HEAD_DIM), 0.02),
        'cd_q_norm_g': 1.0 + nrm(ks[14], (N_ODD, HEAD_DIM), 0.02),
        'cd_k_norm_g': 1.0 + nrm(ks[15], (N_ODD, HEAD_DIM), 0.02),
        'cd_w_out': nrm(ks[16], (N_ODD, CD_OUT_W, D), DEEPNORM_BETA * CD_OUT_W ** -0.5),
        'router_w': nrm(ks[17], (DEPTH, D, N_EXPERTS), D ** -0.5),
        'router_b': nrm(ks[18], (DEPTH, N_EXPERTS), 0.01),
        'expert_w_gu': nrm(ks[19], (DEPTH, N_EXPERTS, D, 2 * EXPERT_FF), D ** -0.5),
        'expert_b_gu': nrm(ks[20], (DEPTH, N_EXPERTS, 2 * EXPERT_FF), 0.02),
        'expert_w_down': nrm(ks[21], (DEPTH, N_EXPERTS, EXPERT_FF, D), DEEPNORM_BETA * EXPERT_FF ** -0.5),
        'expert_b_down': nrm(ks[22], (DEPTH, N_EXPERTS, D), 0.02),
    }


def reference(x, c, ctx, c_ctx, mod_w, mod_b, ln_g, ln_b, ab_w_in, ab_sink, ab_w_out,
              cd_w_in, cd_lambda, cd_subln_g, cd_q_norm_g, cd_k_norm_g, cd_w_out,
              router_w, router_b, expert_w_gu, expert_b_gu, expert_w_down, expert_b_down):
    B, S, D = x.shape
    n_ctx = ctx.shape[1]
    ROWS = S // GRID_W
    cos, sin = _axial_rope_tables(ROWS, HEAD_DIM)
    silu_c = jax.nn.silu(c)
    silu_c_ctx = jax.nn.silu(c_ctx)
    x_lat, x_ctx = x, ctx
    for l in range(DEPTH):
        last = l == DEPTH - 1
        m_lat = (silu_c @ mod_w[l] + mod_b[l])[:, None, :]
        m_ctx = (silu_c_ctx @ mod_w[l] + mod_b[l])[None, None, :]
        sh1, sc1, g1, sh2, sc2, g2 = jnp.split(m_lat, N_MOD, axis=-1)
        csh1, csc1, cg1, csh2, csc2, cg2 = jnp.split(m_ctx, N_MOD, axis=-1)
        h_lat = _modulate(x_lat, sh1, sc1)
        h_ctx = _modulate(x_ctx, csh1, csc1)
        i = l // 2
        if l % 2 == 0:
            y_lat, y_ctx = _ab_mixer(h_lat, h_ctx, ab_w_in[i], ab_sink[i], ab_w_out[i], cos, sin, not last)
        else:
            y_lat, y_ctx = _cd_mixer(h_lat, h_ctx, cd_w_in[i], cd_lambda[i], cd_subln_g[i], cd_q_norm_g[i],
                                     cd_k_norm_g[i], cd_w_out[i], _lambda_init(l), cos, sin, not last)
        x_lat = _post_norm(x_lat, y_lat, g1, ln_g[l, 0], ln_b[l, 0])
        h_lat = _modulate(x_lat, sh2, sc2)
        if not last:
            x_ctx = _post_norm(x_ctx, y_ctx, cg1, ln_g[l, 0], ln_b[l, 0])
            h_ctx = _modulate(x_ctx, csh2, csc2)
            h_all = jnp.concatenate([h_ctx.reshape(B * n_ctx, D), h_lat.reshape(B * S, D)], axis=0)
            f = _moe(h_all, router_w[l], router_b[l], expert_w_gu[l], expert_b_gu[l], expert_w_down[l], expert_b_down[l])
            x_ctx = _post_norm(x_ctx, f[:B * n_ctx].reshape(B, n_ctx, D), cg2, ln_g[l, 1], ln_b[l, 1])
            f_lat = f[B * n_ctx:].reshape(B, S, D)
        else:
            f_lat = _moe(h_lat.reshape(B * S, D), router_w[l], router_b[l], expert_w_gu[l], expert_b_gu[l],
                         expert_w_down[l], expert_b_down[l]).reshape(B, S, D)
        x_lat = _post_norm(x_lat, f_lat, g2, ln_g[l, 1], ln_b[l, 1])
    return x_lat
```

```cpp
#include <hip/hip_runtime.h>
#include <cstdio>
#include <cstdint>

#ifndef MK_MODE
#define MK_MODE 1
#endif

#define LAS __attribute__((address_space(3)))
#define GAS __attribute__((address_space(1)))
typedef unsigned short bf16_t;
typedef short bf16x8 __attribute__((ext_vector_type(8)));
typedef short s16x4 __attribute__((ext_vector_type(4)));
typedef float f32x2 __attribute__((ext_vector_type(2)));
typedef float f32x4 __attribute__((ext_vector_type(4)));
typedef float f32x16 __attribute__((ext_vector_type(16)));
typedef unsigned u32x2 __attribute__((ext_vector_type(2)));
typedef unsigned u32x4 __attribute__((ext_vector_type(4)));
typedef LAS unsigned char* ldsp_t;

constexpr int D = 1024, BATCH = 4, SEQ = 4096, CTXL = 256;
constexpr int NCTX = BATCH * CTXL;
constexpr int NLAT = BATCH * SEQ;
constexpr int NROW = NCTX + NLAT;
constexpr int NE = 32, TOPK = 4, FF = 1024;
constexpr int NMOD = 6 * D;
constexpr int AB_N = 1280;
constexpr int CD_N = 2304;
constexpr float LN_EPS = 1e-6f, RMS_EPS = 1e-6f;
constexpr float DN_ALPHA = 1.41421356237f;
constexpr float LAMBDA_INIT1 = 0.35550907f;
constexpr float QSCALE = 0.125f * 1.4426950408889634f;
constexpr float LOG2E = 1.4426950408889634f;
constexpr float WGU_SCALE = 32.0f, WD_SCALE = 64.0f;
constexpr int RP_MAX = 77824;

constexpr size_t MiB = 1u << 20;
constexpr size_t WS_CTL = 0, CTL_ZERO_BYTES = 1 * MiB;
constexpr size_t WS_MODV = 1 * MiB;
constexpr size_t WS_ROPE = 1 * MiB + 512 * 1024;
constexpr size_t WS_TOPE = 2 * MiB, WS_GATE = 2 * MiB + 512 * 1024, WS_POS = 3 * MiB, WS_SLOT = 3 * MiB + 512 * 1024;
constexpr size_t WS_ADFT = 4 * MiB;
constexpr size_t WS_WF = 9 * MiB;
constexpr size_t WS_WABI = 10 * MiB;
constexpr size_t WS_WABO = 13 * MiB;
constexpr size_t WS_WCDI = 15 * MiB;
constexpr size_t WS_WCDO = 20 * MiB;
constexpr size_t WS_WGU = 32 * MiB;
constexpr size_t WS_WD = 288 * MiB;
constexpr size_t WS_X1 = 416 * MiB;
constexpr size_t WS_XR = 484 * MiB;
constexpr size_t WS_H = 552 * MiB;
constexpr size_t WS_PB = 586 * MiB;
constexpr size_t WS_GT = 664 * MiB;
constexpr size_t WS_GTC = 680 * MiB;
constexpr size_t WS_YF = 681 * MiB;
constexpr size_t WS_O = 697 * MiB;
constexpr size_t WS_Y = 731 * MiB;
constexpr size_t WS_XG = 800 * MiB;
constexpr size_t WS_ACT = 952 * MiB;
constexpr size_t WS_XGE = 1104 * MiB;
constexpr int CAPR = NROW;
constexpr size_t WS_END = (1104 + 544) * MiB;
constexpr int CW_BAR = 4096;
constexpr int CW_CNT = 8192;

constexpr int RING_BYTES = 131072;
constexpr int LDSCTL_OFF = RING_BYTES;
constexpr int MISC_OFF = LDSCTL_OFF + 320;
constexpr int LTAB_OFF = LDSCTL_OFF + 1024;
constexpr int LDS_BYTES = 147456;

#define RLX_AGENT __ATOMIC_RELAXED, __HIP_MEMORY_SCOPE_AGENT
#define LDS_WAIT() asm volatile("s_waitcnt lgkmcnt(0)" ::: "memory")
#define VM_WAIT() asm volatile("s_waitcnt vmcnt(0)" ::: "memory")
__device__ __forceinline__ unsigned f2bf(float f) { unsigned u = __builtin_bit_cast(unsigned, f); return (u + 0x7fffu + ((u >> 16) & 1u)) >> 16; }
__device__ __forceinline__ unsigned pk2(float lo, float hi) { return f2bf(lo) | (f2bf(hi) << 16); }
__device__ __forceinline__ unsigned cvt_pk_bf16(float lo, float hi) { unsigned r; asm volatile("v_cvt_pk_bf16_f32 %0, %1, %2" : "=v"(r) : "v"(lo), "v"(hi)); return r; }
__device__ __forceinline__ unsigned pk4_fp8(float a, float b, float c, float d) { int w = 0; w = __builtin_amdgcn_cvt_pk_fp8_f32(a, b, w, false); w = __builtin_amdgcn_cvt_pk_fp8_f32(c, d, w, true); return (unsigned)w; }
__device__ __forceinline__ float bf2f(unsigned h) { return __builtin_bit_cast(float, h << 16); }
__device__ __forceinline__ int lane_id() { return (int)__builtin_amdgcn_mbcnt_hi(~0u, __builtin_amdgcn_mbcnt_lo(~0u, 0u)); }
constexpr int DPP_XOR1 = 0xB1, DPP_XOR2 = 0x4E, DPP_XOR3 = 0x1B, DPP_XOR7 = 0x141, DPP_XOR15 = 0x140, DPP_XOR8 = 0x128;
template <int CTRL> __device__ __forceinline__ float dppf(float x) { return __builtin_bit_cast(float, __builtin_amdgcn_update_dpp(0, __builtin_bit_cast(int, x), CTRL, 0xF, 0xF, true)); }
template <int CTRL> __device__ __forceinline__ int dppi(int x) { return __builtin_amdgcn_update_dpp(0, x, CTRL, 0xF, 0xF, true); }
__device__ __forceinline__ void swap16(float& a, float& b) { auto r = __builtin_amdgcn_permlane16_swap(__builtin_bit_cast(unsigned, a), __builtin_bit_cast(unsigned, b), false, false); const unsigned r0 = r[0], r1 = r[1]; a = __builtin_bit_cast(float, r0); b = __builtin_bit_cast(float, r1); }
__device__ __forceinline__ void swap32(float& a, float& b) { auto r = __builtin_amdgcn_permlane32_swap(__builtin_bit_cast(unsigned, a), __builtin_bit_cast(unsigned, b), false, false); const unsigned r0 = r[0], r1 = r[1]; a = __builtin_bit_cast(float, r0); b = __builtin_bit_cast(float, r1); }
__device__ __forceinline__ float wave_sum(float v) {
    v += dppf<DPP_XOR1>(v); v += dppf<DPP_XOR2>(v); v += dppf<DPP_XOR7>(v); v += dppf<DPP_XOR15>(v);
    { float a = v, b = v; swap16(a, b); v = a + b; }
    { float a = v, b = v; swap32(a, b); v = a + b; }
    return v;
}

#define XB_TMO      128
#define XB_XCNT(j)  (256  + 64 * (j))
#define XB_XSUB(j)  (1280 + 64 * (j))
#define XB_XGEN(j)  (2304 + 64 * (j))
#define XB_TOP      3328
#define XB_TOPGEN   3392
#define XCD_BAR_WORDS 3456
#define XB_SPIN_CAP (1u << 18)
__device__ __forceinline__ unsigned xb_ld(unsigned* p)              { return __hip_atomic_load(p, __ATOMIC_RELAXED, __HIP_MEMORY_SCOPE_AGENT); }
__device__ __forceinline__ unsigned xb_add(unsigned* p, unsigned v) { return __hip_atomic_fetch_add(p, v, __ATOMIC_RELAXED, __HIP_MEMORY_SCOPE_AGENT); }
__device__ __forceinline__ unsigned xb_xcc_id() { return (unsigned)__builtin_amdgcn_s_getreg((3 << 11) | 20) & 0xFu; }
#define XB_SPIN(cond, bar) do { unsigned _sp = 0; while (cond) { __builtin_amdgcn_s_sleep(1); \
    if ((++_sp & 255u) == 0u) { if (xb_ld(&(bar)[XB_TMO])) break; if (_sp > XB_SPIN_CAP) { atomicAdd(&(bar)[XB_TMO], 1u); break; } } } } while (0)
struct XcdBarrier { unsigned* bar; unsigned x; volatile LAS unsigned* st; };
__device__ __forceinline__ XcdBarrier xcd_barrier_post(unsigned* bar, volatile LAS unsigned* st) {
    XcdBarrier b; b.bar = bar; b.x = xb_xcc_id(); b.st = st;
    if (threadIdx.x == 0) (void)xb_add(&bar[XB_XCNT(b.x)], 1u);
    return b;
}
__device__ __forceinline__ void xcd_barrier_complete(unsigned* bar, unsigned x, unsigned& nloc, unsigned& nx) {
    const unsigned G = gridDim.x * gridDim.y * gridDim.z;
    unsigned sum, cnt, mine, sp = 0u;
    for (;;) {
        sum = 0u; cnt = 0u; mine = 0u;
#pragma unroll
        for (unsigned j = 0; j < 16; ++j) { const unsigned c = xb_ld(&bar[XB_XCNT(j)]); sum += c; cnt += (c > 0u) ? 1u : 0u; mine = (j == x) ? c : mine; }
        if (sum == G) break;
        __builtin_amdgcn_s_sleep(1);
        if ((++sp & 255u) == 0u) { if (xb_ld(&bar[XB_TMO])) break; if (sp > XB_SPIN_CAP) { atomicAdd(&bar[XB_TMO], 1u); break; } }
    }
    nloc = mine > 0u ? mine : 1u; nx = cnt > 0u ? cnt : 1u;
}
__device__ __forceinline__ void xcd_arrive(const XcdBarrier& b) {
    asm volatile("s_waitcnt vmcnt(0)" ::: "memory");
    __syncthreads();
    if (threadIdx.x == 0) {
        unsigned* bar = b.bar;
        __builtin_amdgcn_s_waitcnt(0);
        unsigned nloc = b.st[0], nx = b.st[1];
        if (nloc == 0u) { xcd_barrier_complete(bar, b.x, nloc, nx); b.st[0] = nloc; b.st[1] = nx; }
        const unsigned old = xb_add(&bar[XB_XSUB(b.x)], 1u);
        const unsigned gen = old / nloc;
        if (old + 1u == (gen + 1u) * nloc) {
            __builtin_amdgcn_fence(__ATOMIC_RELEASE, "agent");
            asm volatile("s_waitcnt vmcnt(0)" ::: "memory");
            (void)xb_add(&bar[XB_TOP], 1u);
        }
        b.st[2] = (gen + 1u) * nx;
    }
}
__device__ __forceinline__ void xcd_wait(const XcdBarrier& b) {
    if (threadIdx.x == 0) {
        unsigned* bar = b.bar;
        const unsigned target = b.st[2];
        XB_SPIN(xb_ld(&bar[XB_TOP]) < target, bar);
        __builtin_amdgcn_fence(__ATOMIC_ACQUIRE, "agent");
        asm volatile("s_waitcnt vmcnt(0)" ::: "memory");
    }
    __syncthreads();
}
__device__ __forceinline__ void xcd_barrier(const XcdBarrier& b) { xcd_arrive(b); xcd_wait(b); }

namespace pg8 {
constexpr int BM = 256, BK = 64, HALF = 128, HTB = HALF * BK * 2, STAGE_BYTES = 8 * HTB;
__host__ __device__ __forceinline__ int lds_byte(int r, int c) { const int st = (r >> 4) * 2 + (c >> 5), rr = r & 15, cc = c & 31, ob = rr * 64 + cc * 2; return st * 1024 + (ob ^ (((ob >> 9) & 1) << 5)); }
__host__ __device__ __forceinline__ void stage_rc(int b, int& R, int& C) { const int st = b / 1024, sb = b % 1024, swz = sb ^ (((sb >> 9) & 1) << 5); R = (st >> 1) * 16 + swz / 64; C = (st & 1) * 32 + (swz % 64) / 2; }
__host__ __device__ __forceinline__ int perm32(int rho) { const int n = rho >> 4, i = rho & 15; return 8 * (i >> 2) + 4 * n + (i & 3); }

struct Unit { int pm, pn, aux, rot; const char* a; const char* b; };
struct Gemm { int nkt; unsigned lda, ldb, ksA = 128u, ksB = 128u; };

typedef int i32x8 __attribute__((ext_vector_type(8)));
typedef int i32x4 __attribute__((ext_vector_type(4)));
__device__ __forceinline__ i32x8 cat8(bf16x8 lo, bf16x8 hi) { return __builtin_shufflevector(__builtin_bit_cast(i32x4, lo), __builtin_bit_cast(i32x4, hi), 0, 1, 2, 3, 4, 5, 6, 7); }
template <class Epi, class Sched, bool ALIGN_EPI = false, bool SP2 = false, bool FP8 = false>
__device__ __forceinline__ void gemm_phase(ldsp_t lds, const Gemm g, const Sched& S, const Epi& E, const int wid) {
    const int lane = lane_id(), tid = wid * 64 + lane; const int wr = wid >> 2, wc = wid & 3, fr = lane & 15, fq = lane >> 4;
    int nt = g.nkt; asm volatile("" : "+s"(nt));
    unsigned voffA, voffB;
    { int R, C; stage_rc(tid * 16, R, C); const int Rb = Epi::PERM ? ((R & ~31) + perm32(R & 31)) : R;
      voffA = (unsigned)R * g.lda + (unsigned)C * 2u; voffB = (unsigned)Rb * g.ldb + (unsigned)C * 2u; }
    const size_t p1A = (size_t)64 * g.lda, p1B = (size_t)64 * g.ldb;
    const size_t kstepA = g.ksA, kstepB = g.ksB;
    const size_t hstepA = (size_t)HALF * g.lda, hstepB = (size_t)HALF * g.ldb;
    const unsigned ldsw = (unsigned)wid * 1024u;
    const int aoff = lds_byte(wr * 64 + fr, fq * 8), boff = lds_byte(wc * 32 + fr, fq * 8);
    constexpr int KFS = 1024;
#define PG8_SA(b, h) (((b) * 2 + (h)) * HTB)
#define PG8_SB(b, h) ((4 + (b) * 2 + (h)) * HTB)
#define PG8_STAGE(bufoff, gbase, voff) do { \
        __builtin_amdgcn_global_load_lds((const unsigned*)((const char*)(gbase) + (voff)), (LAS unsigned*)(lds + (bufoff) + ldsw), 16, 0, 0); \
        __builtin_amdgcn_global_load_lds((const unsigned*)((const char*)(gbase) + ((&(voff) == &voffA) ? p1A : p1B) + (voff)), (LAS unsigned*)(lds + (bufoff) + ldsw + 8192), 16, 0, 0); } while (0)
#define PG8_LDA(dst, b, h) do { _Pragma("unroll") for (int m = 0; m < 4; ++m) _Pragma("unroll") for (int k = 0; k < 2; ++k) dst[m][k] = *(const LAS bf16x8*)(lds + PG8_SA(b, h) + aoff + m * 2048 + k * KFS); } while (0)
#define PG8_LDB(dst, b, h) do { _Pragma("unroll") for (int n = 0; n < 2; ++n) _Pragma("unroll") for (int k = 0; k < 2; ++k) dst[n][k] = *(const LAS bf16x8*)(lds + PG8_SB(b, h) + boff + n * 2048 + k * KFS); } while (0)
#define PG8_MMA(ai, bj, At, Bt) do { __builtin_amdgcn_s_setprio(1); _Pragma("unroll") for (int m = 0; m < 4; ++m) _Pragma("unroll") for (int n = 0; n < 2; ++n) { \
        if constexpr (FP8) acc[ai][bj][m][n] = __builtin_amdgcn_mfma_scale_f32_16x16x128_f8f6f4(cat8(Bt[n][0], Bt[n][1]), cat8(At[m][0], At[m][1]), acc[ai][bj][m][n], 0, 0, 0, 0, 0, 0); \
        else { _Pragma("unroll") for (int k = 0; k < 2; ++k) acc[ai][bj][m][n] = __builtin_amdgcn_mfma_f32_16x16x32_bf16(Bt[n][k], At[m][k], acc[ai][bj][m][n], 0, 0, 0); } } \
        __builtin_amdgcn_s_setprio(0); } while (0)
#define PG8_WAIT_V(n) asm volatile("s_waitcnt vmcnt(" #n ")" ::: "memory")
#define PG8_WAIT_L(n) asm volatile("s_waitcnt lgkmcnt(" #n ")" ::: "memory")
#define PG8_BAR __builtin_amdgcn_s_barrier()
#define PG8_SCHED __builtin_amdgcn_sched_barrier(0)
    Unit cur, nxt; int ui = 0;
    if (!S.next(0, cur)) return;
    f32x4 acc[2][2][4][2];
#pragma unroll
    for (int a = 0; a < 2; ++a)
#pragma unroll
        for (int b = 0; b < 2; ++b)
#pragma unroll
            for (int m = 0; m < 4; ++m)
#pragma unroll
                for (int n = 0; n < 2; ++n) acc[a][b][m][n] = (f32x4){0.f, 0.f, 0.f, 0.f};
    bf16x8 At[4][2], B0[2][2], B1[2][2];
    const int km = nt - 1;
#define PG8_KA(t, rot) ((size_t)((((t) + (rot)) & km)) * kstepA)
#define PG8_KB(t, rot) ((size_t)((((t) + (rot)) & km)) * kstepB)
    const char* cA = cur.a; const char* cB = cur.b; int cr = cur.rot & km;
    if constexpr (SP2) {
        PG8_STAGE(PG8_SB(0, 0), cB + PG8_KB(0, cr), voffB); PG8_STAGE(PG8_SB(0, 1), cB + hstepB + PG8_KB(0, cr), voffB); PG8_STAGE(PG8_SA(0, 0), cA + PG8_KA(0, cr), voffA); PG8_STAGE(PG8_SA(0, 1), cA + hstepA + PG8_KA(0, cr), voffA);
        if (wr == 1) PG8_BAR;
        PG8_WAIT_V(2); PG8_BAR;
        PG8_STAGE(PG8_SB(1, 0), cB + PG8_KB(1, cr), voffB); PG8_STAGE(PG8_SA(1, 0), cA + PG8_KA(1, cr), voffA); PG8_STAGE(PG8_SB(1, 1), cB + hstepB + PG8_KB(1, cr), voffB);
        PG8_WAIT_V(6); PG8_BAR;
    } else {
        PG8_STAGE(PG8_SB(0, 0), cB + PG8_KB(0, cr), voffB); PG8_STAGE(PG8_SA(0, 0), cA + PG8_KA(0, cr), voffA); PG8_STAGE(PG8_SB(0, 1), cB + hstepB + PG8_KB(0, cr), voffB); PG8_STAGE(PG8_SA(0, 1), cA + hstepA + PG8_KA(0, cr), voffA);
        if (wr == 1) PG8_BAR;
        PG8_WAIT_V(4); PG8_BAR;
        PG8_STAGE(PG8_SB(1, 0), cB + PG8_KB(1, cr), voffB); PG8_STAGE(PG8_SA(1, 0), cA + PG8_KA(1, cr), voffA); PG8_STAGE(PG8_SB(1, 1), cB + hstepB + PG8_KB(1, cr), voffB);
        PG8_WAIT_V(6); PG8_BAR;
    }
    for (;;) {
        const bool has_next = S.next(ui + 1, nxt);
        const char* nA = has_next ? nxt.a : cA; const char* nB = has_next ? nxt.b : cB; const int nr = has_next ? (nxt.rot & km) : cr;
        for (int t = 0; t < nt; t += 2) {
            const bool last = (t == nt - 2);
            const char* a1 = cA + PG8_KA(t + 1, cr);
            const char* a2 = last ? nA + PG8_KA(0, nr) : cA + PG8_KA(t + 2, cr); const char* b2 = last ? nB + PG8_KB(0, nr) : cB + PG8_KB(t + 2, cr);
            const char* a3 = last ? nA + PG8_KA(1, nr) : cA + PG8_KA(t + 3, cr); const char* b3 = last ? nB + PG8_KB(1, nr) : cB + PG8_KB(t + 3, cr);
            if constexpr (SP2) {
            PG8_LDB(B0, 0, 0); PG8_LDB(B1, 0, 1); PG8_SCHED; PG8_LDA(At, 0, 0); PG8_STAGE(PG8_SA(1, 1), a1 + hstepA, voffA);
            PG8_WAIT_V(8); PG8_WAIT_L(0); PG8_BAR; PG8_MMA(0, 0, At, B0); PG8_MMA(0, 1, At, B1); PG8_BAR; PG8_SCHED;
            PG8_LDA(At, 0, 1); PG8_STAGE(PG8_SB(0, 0), b2, voffB); PG8_STAGE(PG8_SB(0, 1), b2 + hstepB, voffB); PG8_STAGE(PG8_SA(0, 0), a2, voffA);
            PG8_WAIT_V(8); PG8_WAIT_L(0); PG8_BAR; PG8_MMA(1, 0, At, B0); PG8_MMA(1, 1, At, B1); PG8_BAR; PG8_SCHED;
            PG8_LDB(B0, 1, 0); PG8_LDB(B1, 1, 1); PG8_SCHED; PG8_LDA(At, 1, 0); PG8_STAGE(PG8_SA(0, 1), a2 + hstepA, voffA);
            PG8_WAIT_V(8); PG8_WAIT_L(0); PG8_BAR; PG8_MMA(0, 0, At, B0); PG8_MMA(0, 1, At, B1); PG8_BAR; PG8_SCHED;
            PG8_LDA(At, 1, 1); PG8_STAGE(PG8_SB(1, 0), b3, voffB); PG8_STAGE(PG8_SB(1, 1), b3 + hstepB, voffB); PG8_STAGE(PG8_SA(1, 0), a3, voffA);
            PG8_WAIT_V(8); PG8_WAIT_L(0); PG8_BAR; PG8_MMA(1, 0, At, B0); PG8_MMA(1, 1, At, B1); PG8_BAR; PG8_SCHED;
            } else {
            PG8_LDB(B0, 0, 0); PG8_SCHED; PG8_LDA(At, 0, 0); PG8_STAGE(PG8_SA(1, 1), a1 + hstepA, voffA);
            PG8_WAIT_L(8); PG8_BAR; PG8_WAIT_L(0); PG8_MMA(0, 0, At, B0); PG8_BAR; PG8_SCHED;
            PG8_LDB(B1, 0, 1); PG8_STAGE(PG8_SB(0, 0), b2, voffB);
            PG8_BAR; PG8_WAIT_L(0); PG8_MMA(0, 1, At, B1); PG8_BAR;
            PG8_LDA(At, 0, 1); PG8_STAGE(PG8_SA(0, 0), a2, voffA);
            PG8_BAR; PG8_WAIT_L(0); PG8_MMA(1, 0, At, B0); PG8_BAR; PG8_SCHED;
            PG8_STAGE(PG8_SB(0, 1), b2 + hstepB, voffB);
            PG8_WAIT_V(6); PG8_BAR; PG8_MMA(1, 1, At, B1); PG8_BAR;
            PG8_LDB(B0, 1, 0); PG8_SCHED; PG8_LDA(At, 1, 0); PG8_STAGE(PG8_SA(0, 1), a2 + hstepA, voffA);
            PG8_WAIT_L(8); PG8_BAR; PG8_WAIT_L(0); PG8_MMA(0, 0, At, B0); PG8_BAR; PG8_SCHED;
            PG8_LDB(B1, 1, 1); PG8_STAGE(PG8_SB(1, 0), b3, voffB);
            PG8_BAR; PG8_WAIT_L(0); PG8_MMA(0, 1, At, B1); PG8_BAR;
            PG8_LDA(At, 1, 1); PG8_STAGE(PG8_SA(1, 0), a3, voffA);
            PG8_BAR; PG8_WAIT_L(0); PG8_MMA(1, 0, At, B0); PG8_BAR; PG8_SCHED;
            PG8_STAGE(PG8_SB(1, 1), b3 + hstepB, voffB);
            PG8_WAIT_V(6); PG8_BAR; PG8_MMA(1, 1, At, B1); PG8_BAR;
            }
        }
        if constexpr (ALIGN_EPI) { if (wr == 0) PG8_BAR; }
#ifndef PROBE_EPI2
#define PROBE_EPI2 0
#endif
        { int lane_e = lane_id(); asm volatile("" : "+v"(lane_e)); E(acc, cur, wr, wc, lane_e & 15, lane_e >> 4); if (PROBE_EPI2 && FP8) { asm volatile("" : "+v"(lane_e)); E(acc, cur, wr, wc, lane_e & 15, lane_e >> 4); } }
        if (!has_next) break;
#pragma unroll
        for (int a = 0; a < 2; ++a)
#pragma unroll
            for (int b = 0; b < 2; ++b)
#pragma unroll
                for (int m = 0; m < 4; ++m)
#pragma unroll
                    for (int n = 0; n < 2; ++n) acc[a][b][m][n] = (f32x4){0.f, 0.f, 0.f, 0.f};
        cur = nxt; cA = nA; cB = nB; cr = nr; ++ui;
        if constexpr (ALIGN_EPI) { if (wr == 1) PG8_BAR; }
    }
    PG8_WAIT_V(0);
    if constexpr (!ALIGN_EPI) { if (wr == 0) PG8_BAR; }
    PG8_BAR;
#undef PG8_KA
#undef PG8_KB
#undef PG8_SA
#undef PG8_SB
#undef PG8_STAGE
#undef PG8_LDA
#undef PG8_LDB
#undef PG8_MMA
#undef PG8_WAIT_V
#undef PG8_WAIT_L
#undef PG8_BAR
#undef PG8_SCHED
}
}
#ifndef PG8_SP2
#define PG8_SP2 true
#endif
#ifndef PG8_ALIGN
#define PG8_ALIGN true
#endif

struct Args { const float* in[23]; float* out; unsigned char* ws; int ph_lo, ph_hi; };
typedef const float* cfptr_t;
struct KArgs { const __attribute__((address_space(4))) unsigned char* p;
    __device__ __forceinline__ const float* in(int k) const { return *(const __attribute__((address_space(4))) cfptr_t*)(p + 8 * k); } };
struct Frame {
    ldsp_t lds;
    int tid, lane, wave, vcu, G;
    unsigned char* ws;
};
#define WSP(T, off) ((T*)(F.ws + (off)))

struct GridOrder {
    int nM, nN, G, c; const char* A; const char* B; size_t a_tile, b_tile;
    __device__ __forceinline__ void init(int nM_, int nN_, int G_, int vcu, int shift, const void* A_, size_t a_tile_, const void* B_, size_t b_tile_) {
        nM = nM_; nN = nN_; G = G_; c = (vcu + G_ - (shift % G_)) % G_; A = (const char*)A_; B = (const char*)B_; a_tile = a_tile_; b_tile = b_tile_; }
    __device__ __forceinline__ bool next(int i, pg8::Unit& u) const {
        const int L = i * G + c; if (L >= nM * nN) return false;
        u.pm = L / nN; u.pn = L % nN; u.aux = 0; u.rot = 0; u.a = A + (size_t)u.pm * a_tile; u.b = B + (size_t)u.pn * b_tile; return true; }
};
struct MoeOrder {
    int nN, per, j, T0, T1, a_cap; const LAS int* tile_e; const char* A; const char* B; size_t a_tile, b_tile, b_exp;
    __device__ __forceinline__ bool next(int i, pg8::Unit& u) const {
        const int Ll = i * per + j; if (Ll >= (T1 - T0) * nN) return false;
        u.pm = T0 + Ll / nN; u.pn = Ll % nN; const int e = __builtin_amdgcn_readfirstlane(tile_e[u.pm]); u.aux = e; u.rot = u.pn + 2 * (u.pm & 3);
        const int at = a_cap ? e * a_cap + (u.pm - __builtin_amdgcn_readfirstlane(tile_e[320 + e])) : u.pm;
        u.a = A + (size_t)at * a_tile; u.b = B + (size_t)e * b_exp + (size_t)u.pn * b_tile; return true; }
};
struct FourierOrder {
    int G, c; const char* A; const char* YF; const char* GTC;
    __device__ __forceinline__ bool next(int i, pg8::Unit& u) const {
        const int L = i * G + c; if (L >= 68) return false;
        const int gi = L >> 2, b = L & 3; u.pm = gi; u.pn = b; u.aux = 0; u.rot = 0;
        u.a = A + (size_t)gi * (256u * 1024u);
        u.b = gi < 16 ? YF + ((size_t)gi * 1024u + (size_t)b * 256u) * 1024u : GTC + (size_t)b * (256u * 1024u);
        return true; }
};

__device__ __forceinline__ void st_bf16x4(bf16_t* p, f32x4 v) { u32x2 w; w.x = cvt_pk_bf16(v[0], v[1]); w.y = cvt_pk_bf16(v[2], v[3]); *(u32x2*)p = w; }
__device__ __forceinline__ void st_bf16x8(bf16_t* p, f32x4 v0, f32x4 v1) { u32x4 w; w.x = cvt_pk_bf16(v0[0], v0[1]); w.y = cvt_pk_bf16(v0[2], v0[3]); w.z = cvt_pk_bf16(v1[0], v1[1]); w.w = cvt_pk_bf16(v1[2], v1[3]); *(u32x4*)p = w; }

struct EpiIn0 {
    static constexpr bool PERM = true;
    bf16_t* P; const float* ropec; const float* ropes;
    __device__ __forceinline__ void operator()(const f32x4 (&acc)[2][2][4][2], const pg8::Unit& u, int wr, int wc, int fr, int fq) const {
        const int pn = u.pn; const int colbase = pn * 256 + wc * 64;
        const float qs = (pn <= 2) ? QSCALE : 1.0f;
#pragma unroll
        for (int ai = 0; ai < 2; ++ai)
#pragma unroll
            for (int m = 0; m < 4; ++m) {
                const int row = u.pm * 256 + ai * 128 + wr * 64 + m * 16 + fr;
                const bool rot = (row >= NCTX) && (pn <= 3);
                const int t = (row - NCTX) & (SEQ - 1);
                bf16_t* rp = P + (size_t)row * AB_N + colbase + 8 * fq;
#pragma unroll
                for (int bj = 0; bj < 2; ++bj) {
                    f32x4 x0 = acc[ai][bj][m][0], x1 = acc[ai][bj][m][1];
                    if (rot) { const int pos = bj ? (t & 63) : (t >> 6);
                        const f32x4 c = *(const f32x4*)(ropec + pos * 16 + 4 * fq), s = *(const f32x4*)(ropes + pos * 16 + 4 * fq);
                        const f32x4 y0 = x0 * c - x1 * s, y1 = x1 * c + x0 * s; x0 = y0; x1 = y1; }
                    x0 = x0 * qs; x1 = x1 * qs;
                    st_bf16x8(rp + 32 * bj, x0, x1);
                }
            }
    }
};
struct EpiIn1 {
    static constexpr bool PERM = true;
    bf16_t* P; const float* ropec; const float* ropes; const float* qg; const float* kg;
    __device__ __forceinline__ void operator()(const f32x4 (&acc)[2][2][4][2], const pg8::Unit& u, int wr, int wc, int fr, int fq) const {
        const int gidx = u.pn * 4 + wc;
        const bool isq = gidx < 16, norm = (gidx >= 8 && gidx < 16) || gidx == 24 || gidx == 25, ropeable = gidx < 26;
        const float* gv = (gidx < 16) ? qg : kg;
        const float qs = isq ? QSCALE : 1.0f;
        f32x4 g4[2][2];
#pragma unroll
        for (int bj = 0; bj < 2; ++bj)
#pragma unroll
            for (int n = 0; n < 2; ++n) g4[bj][n] = norm ? *(const f32x4*)(gv + 32 * bj + 16 * n + 4 * fq) : (f32x4){1.f, 1.f, 1.f, 1.f};
#pragma unroll
        for (int ai = 0; ai < 2; ++ai)
#pragma unroll
            for (int m = 0; m < 4; ++m) {
                const int row = u.pm * 256 + ai * 128 + wr * 64 + m * 16 + fr;
                const bool rot = (row >= NCTX) && ropeable;
                const int t = (row - NCTX) & (SEQ - 1);
                float rs = 1.0f;
                if (norm) { float ss = 0.f;
#pragma unroll
                    for (int bj = 0; bj < 2; ++bj)
#pragma unroll
                        for (int n = 0; n < 2; ++n) { const f32x4 x = acc[ai][bj][m][n]; ss += (x[0] * x[0] + x[1] * x[1]) + (x[2] * x[2] + x[3] * x[3]); }
                    { float sa = ss, sb = ss; swap16(sa, sb); ss = sa + sb; sa = ss; sb = ss; swap32(sa, sb); ss = sa + sb; }
                    rs = 1.0f / sqrtf(ss * (1.0f / 64.0f) + RMS_EPS); }
                bf16_t* rp = P + (size_t)row * CD_N + gidx * 64 + 8 * fq;
#pragma unroll
                for (int bj = 0; bj < 2; ++bj) {
                    f32x4 x0 = acc[ai][bj][m][0] * rs * g4[bj][0], x1 = acc[ai][bj][m][1] * rs * g4[bj][1];
                    if (rot) { const int pos = bj ? (t & 63) : (t >> 6);
                        const f32x4 c = *(const f32x4*)(ropec + pos * 16 + 4 * fq), s = *(const f32x4*)(ropes + pos * 16 + 4 * fq);
                        const f32x4 y0 = x0 * c - x1 * s, y1 = x1 * c + x0 * s; x0 = y0; x1 = y1; }
                    x0 = x0 * qs; x1 = x1 * qs;
                    st_bf16x8(rp + 32 * bj, x0, x1);
                }
            }
    }
};
struct EpiGT {
    static constexpr bool PERM = true;
    bf16_t* GT; bf16_t* GTC;
    __device__ __forceinline__ void operator()(const f32x4 (&acc)[2][2][4][2], const pg8::Unit& u, int wr, int wc, int fr, int fq) const {
        const int s = u.pm, tok0 = u.pn * 256;
        bf16_t* base; int T, b, t0;
        if (tok0 < NCTX) { b = tok0 >> 8; t0 = 0; T = CTXL; base = GTC; } else { b = (tok0 - NCTX) >> 12; t0 = (tok0 - NCTX) & (SEQ - 1); T = SEQ; base = GT; }
#pragma unroll
        for (int ai = 0; ai < 2; ++ai)
#pragma unroll
            for (int m = 0; m < 4; ++m) { const int cp = ai * 128 + wr * 64 + m * 16 + fr;
                bf16_t* rp = base + ((size_t)((b * 256 + cp) * 2 + s)) * T + t0 + wc * 32 + 8 * fq;
#pragma unroll
                for (int bj = 0; bj < 2; ++bj) st_bf16x8(rp + bj * 128, acc[ai][bj][m][0], acc[ai][bj][m][1]);
            }
    }
};
struct EpiFour {
    static constexpr bool PERM = true;
    bf16_t* O;
    __device__ __forceinline__ void operator()(const f32x4 (&acc)[2][2][4][2], const pg8::Unit& u, int wr, int wc, int fr, int fq) const {
        const int gi = u.pm, b = u.pn;
#pragma unroll
        for (int ai = 0; ai < 2; ++ai)
#pragma unroll
            for (int m = 0; m < 4; ++m) { const int t2 = ai * 128 + wr * 64 + m * 16 + fr;
                const int row = gi < 16 ? NCTX + b * SEQ + gi + 16 * t2 : b * CTXL + t2;
                bf16_t* rp = O + (size_t)row * D + wc * 32 + 8 * fq;
#pragma unroll
                for (int bj = 0; bj < 2; ++bj) st_bf16x8(rp + bj * 128, acc[ai][bj][m][0], acc[ai][bj][m][1]);
            }
    }
};
struct EpiY {
    static constexpr bool PERM = true;
    bf16_t* Y; int ldc;
    __device__ __forceinline__ void operator()(const f32x4 (&acc)[2][2][4][2], const pg8::Unit& u, int wr, int wc, int fr, int fq) const {
#pragma unroll
        for (int ai = 0; ai < 2; ++ai)
#pragma unroll
            for (int m = 0; m < 4; ++m) { bf16_t* rp = Y + (size_t)(u.pm * 256 + ai * 128 + wr * 64 + m * 16 + fr) * ldc + u.pn * 256 + wc * 64 + 8 * fq;
#pragma unroll
                for (int bj = 0; bj < 2; ++bj) st_bf16x8(rp + bj * 32, acc[ai][bj][m][0], acc[ai][bj][m][1]); }
    }
};
struct EpiSwiglu {
    static constexpr bool PERM = true;
    unsigned char* ACT; const float* bgu;
    __device__ __forceinline__ void operator()(const f32x4 (&acc)[2][2][4][2], const pg8::Unit& u, int wr, int wc, int fr, int fq) const {
        const int col = u.pn * 128 + wc * 32 + 8 * fq; const float* bb = bgu + (size_t)u.aux * 2048 + col;
        const f32x4 bg0 = *(const f32x4*)bb, bg1 = *(const f32x4*)(bb + 4), bu0 = *(const f32x4*)(bb + 1024) + 1.0f, bu1 = *(const f32x4*)(bb + 1028) + 1.0f;
#pragma unroll
        for (int ai = 0; ai < 2; ++ai)
#pragma unroll
            for (int m = 0; m < 4; ++m) {
                f32x4 o[2];
#pragma unroll
                for (int n = 0; n < 2; ++n) { const f32x4 sc4 = (f32x4){1.0f / WGU_SCALE, 1.0f / WGU_SCALE, 1.0f / WGU_SCALE, 1.0f / WGU_SCALE};
                    const f32x4 gg = __builtin_elementwise_fma(acc[ai][0][m][n], sc4, n ? bg1 : bg0), uu = __builtin_elementwise_fma(acc[ai][1][m][n], sc4, n ? bu1 : bu0);
#pragma unroll
                    for (int e = 0; e < 4; e += 2) {
                        const f32x2 gc = (f32x2){fminf(gg[e], 7.0f), fminf(gg[e + 1], 7.0f)}, uc1 = (f32x2){fminf(fmaxf(uu[e], -6.0f), 8.0f), fminf(fmaxf(uu[e + 1], -6.0f), 8.0f)};
                        const f32x2 t = gc * (-1.702f * LOG2E);
                        const f32x2 d = (f32x2){__builtin_amdgcn_exp2f(t.x), __builtin_amdgcn_exp2f(t.y)} + 1.0f;
                        const f32x2 r = (f32x2){__builtin_amdgcn_rcpf(d.x), __builtin_amdgcn_rcpf(d.y)};
                        const f32x2 res = uc1 * (gc * r); o[n][e] = res.x; o[n][e + 1] = res.y; } }
                u32x2 w; w.x = pk4_fp8(o[0][0], o[0][1], o[0][2], o[0][3]); w.y = pk4_fp8(o[1][0], o[1][1], o[1][2], o[1][3]);
                *(u32x2*)(ACT + ((size_t)(u.pm * 8 + u.pn) * 256 + (ai * 128 + wr * 64 + m * 16 + fr)) * 128 + wc * 32 + 8 * fq) = w;
            }
    }
};
struct EpiDown {
    static constexpr bool PERM = true;
    unsigned char* YB; const float* bd;
    __device__ __forceinline__ void operator()(const f32x4 (&acc)[2][2][4][2], const pg8::Unit& u, int wr, int wc, int fr, int fq) const {
        const int col0 = u.pn * 256 + wc * 64 + 16 * fq; const float* bb = bd + (size_t)u.aux * 1024 + col0;
        f32x4 bv[2][2];
#pragma unroll
        for (int bj = 0; bj < 2; ++bj)
#pragma unroll
            for (int n = 0; n < 2; ++n) bv[bj][n] = *(const f32x4*)(bb + bj * 8 + 4 * n);
#pragma unroll
        for (int ai = 0; ai < 2; ++ai)
#pragma unroll
            for (int m = 0; m < 4; ++m) { unsigned char* rp = YB + (size_t)(u.pm * 256 + ai * 128 + wr * 64 + m * 16 + fr) * D + col0;
                u32x4 w;
#pragma unroll
                for (int bj = 0; bj < 2; ++bj) { const f32x4 sc4 = (f32x4){1.0f / WD_SCALE, 1.0f / WD_SCALE, 1.0f / WD_SCALE, 1.0f / WD_SCALE};
                    const f32x4 a = __builtin_elementwise_fma(acc[ai][bj][m][0], sc4, bv[bj][0]), b = __builtin_elementwise_fma(acc[ai][bj][m][1], sc4, bv[bj][1]);
                    w[2 * bj] = pk4_fp8(a[0], a[1], a[2], a[3]); w[2 * bj + 1] = pk4_fp8(b[0], b[1], b[2], b[3]); }
                *(u32x4*)rp = w; }
    }
};

namespace att {
constexpr float THR = 8.0f;
__device__ __forceinline__ float max3f(float a, float b, float c) { float r; asm("v_max3_f32 %0, %1, %2, %3" : "=v"(r) : "v"(a), "v"(b), "v"(c)); return r; }
__device__ __forceinline__ float max2f(float a, float b) { float r; asm("v_max_f32_e32 %0, %1, %2" : "=v"(r) : "v"(a), "v"(b)); return r; }
template <int DV, int NK = 64> struct StV { u32x4 v[DV * NK / 4096]; };
template <int NK = 64> struct StK { u32x4 k[NK / 64]; };
template <int NK> __device__ __forceinline__ void load_k(StK<NK>& s, const bf16_t* K, int kp, int row0, int tid) {
#pragma unroll
    for (int i = 0; i < NK / 64; ++i) { const int idx = tid + 512 * i, key = idx >> 3, ch = idx & 7; s.k[i] = *(const u32x4*)(K + (size_t)(row0 + key) * kp + ch * 8); }
}
template <int NK> __device__ __forceinline__ void write_k(const StK<NK>& s, ldsp_t kb, int tid) {
#pragma unroll
    for (int i = 0; i < NK / 64; ++i) { const int idx = tid + 512 * i, key = idx >> 3, ch = idx & 7; *(LAS u32x4*)(kb + key * 128 + ((ch ^ ((key >> 1) & 7)) << 4)) = s.k[i]; }
}
template <int DV, int NK> __device__ __forceinline__ void load_v(StV<DV, NK>& s, const bf16_t* V, int vp, int row0, int tid) {
#pragma unroll
    for (int i = 0; i < DV * NK / 4096; ++i) { const int idx = tid + 512 * i, key = idx / (DV / 8), ch = idx % (DV / 8); s.v[i] = *(const u32x4*)(V + (size_t)(row0 + key) * vp + ch * 8); }
}
template <int DV, int NK> __device__ __forceinline__ void write_v(const StV<DV, NK>& s, ldsp_t vb, int tid) {
#pragma unroll
    for (int i = 0; i < DV * NK / 4096; ++i) { const int idx = tid + 512 * i, key = idx / (DV / 8), ch = idx % (DV / 8);
        *(LAS u32x4*)(vb + ((key >> 3) * (DV / 32) + (ch >> 2)) * 512 + (key & 7) * 64 + (ch & 3) * 16) = s.v[i]; }
}
__device__ __forceinline__ s16x4 vtr(ldsp_t p) { return __builtin_bit_cast(s16x4, __builtin_amdgcn_ds_read_tr16_b64_v4i16((LAS s16x4*)p)); }
__device__ __forceinline__ void qk(f32x16& p0, f32x16& p1, ldsp_t kb, const bf16x8 (&qf)[4], const f32x16& cinit, int koff0, int koff1, int kx0, int kx1, int h) {
    bf16x8 a0[4], a1[4];
#pragma unroll
    for (int s = 0; s < 4; ++s) { a0[s] = *(const LAS bf16x8*)(kb + koff0 + (((2 * s + h) ^ kx0) << 4)); a1[s] = *(const LAS bf16x8*)(kb + koff1 + (((2 * s + h) ^ kx1) << 4)); }
    __builtin_amdgcn_sched_barrier(0);
    p0 = __builtin_amdgcn_mfma_f32_32x32x16_bf16(a0[0], qf[0], cinit, 0, 0, 0); p1 = __builtin_amdgcn_mfma_f32_32x32x16_bf16(a1[0], qf[0], cinit, 0, 0, 0);
#pragma unroll
    for (int s = 1; s < 4; ++s) { p0 = __builtin_amdgcn_mfma_f32_32x32x16_bf16(a0[s], qf[s], p0, 0, 0, 0); p1 = __builtin_amdgcn_mfma_f32_32x32x16_bf16(a1[s], qf[s], p1, 0, 0, 0); }
}
__device__ __forceinline__ float rowmax(const f32x16& p0, const f32x16& p1) {
    float a = max3f(p0[0], p0[1], p1[0]), b = max3f(p0[2], p0[3], p1[1]); a = max3f(a, p1[2], p1[3]);
#pragma unroll
    for (int i = 4; i < 16; i += 4) { a = max3f(a, p0[i], p0[i + 1]); b = max3f(b, p0[i + 2], p0[i + 3]); a = max3f(a, p1[i], p1[i + 1]); b = max3f(b, p1[i + 2], p1[i + 3]); }
    float m = max2f(a, b), m2 = m; swap32(m, m2); return max2f(m, m2);
}
#define ATT_SB() __builtin_amdgcn_sched_barrier(0)
template <int DV, bool WINDOW>
__device__ __forceinline__ void sm_head(f32x16& p0, f32x16& p1, float& m, float& l, f32x16& negm, f32x16 (&o)[DV / 32], bool masked, int kp0, int qpos, int h) {
    if (WINDOW && masked) {
        const int wq0 = __builtin_amdgcn_readfirstlane(qpos - (int)(__builtin_amdgcn_mbcnt_hi(~0u, __builtin_amdgcn_mbcnt_lo(~0u, 0u)) & 31u));
        const bool inside = (kp0 >= wq0 + 31 - 128) && (kp0 + 63 <= wq0 + 128);
        const bool outside = (kp0 > wq0 + 31 + 128) || (kp0 + 63 < wq0 - 128);
        if (outside) {
#pragma unroll
            for (int i = 0; i < 16; ++i) { p0[i] = -1e30f; p1[i] = -1e30f; }
        } else if (!inside) {
#pragma unroll
            for (int i = 0; i < 16; ++i) { const int kpos = kp0 + (i & 3) + 8 * (i >> 2) + 4 * h; const int d0 = qpos - kpos, d1 = d0 - 32;
                if (d0 > 128 || d0 < -128) p0[i] = -1e30f; if (d1 > 128 || d1 < -128) p1[i] = -1e30f; }
        }
    }
    const float mx = rowmax(p0, p1);
    if (__any(mx > THR)) {
        const float inc = fmaxf(mx, 0.f), alpha = __builtin_amdgcn_exp2f(-inc);
        m += inc; l *= alpha;
#pragma unroll
        for (int c = 0; c < DV / 32; ++c)
#pragma unroll
            for (int i = 0; i < 16; ++i) o[c][i] *= alpha;
#pragma unroll
        for (int i = 0; i < 16; ++i) { p0[i] -= inc; p1[i] -= inc; negm[i] = -m; }
    }
}
template <int DV, bool PIPE>
__device__ __forceinline__ void fused_body(f32x16& c0, f32x16& c1, f32x16& n0, f32x16& n1, ldsp_t kbn, ldsp_t vb, const bf16x8 (&qf)[4], const f32x16& negm, f32x16 (&o)[DV / 32], float& l,
                                           int koff0, int koff1, int kx0, int kx1, int h, int voff) {
    constexpr int NC = DV / 32;
#define ATT_LDK(half, s) (*(const LAS bf16x8*)(kbn + ((half) ? koff1 : koff0) + (((2 * (s) + h) ^ ((half) ? kx1 : kx0)) << 4)))
#define ATT_EXP8(p, i0) do { _Pragma("unroll") for (int i_ = 0; i_ < 8; ++i_) { p[(i0) + i_] = __builtin_amdgcn_exp2f(p[(i0) + i_]); ls += p[(i0) + i_]; } } while (0)
#define ATT_LDV(dst, ks) do { _Pragma("unroll") for (int c_ = 0; c_ < NC; ++c_) { const int kb8_ = 4 * ((ks) >> 1) + 2 * ((ks) & 1); \
        dst[c_][0] = vtr(vb + voff + ((kb8_ + 0) * NC + c_) * 512); dst[c_][1] = vtr(vb + voff + ((kb8_ + 1) * NC + c_) * 512); } } while (0)
#define ATT_PV(vf, pfv) do { _Pragma("unroll") for (int c_ = 0; c_ < NC; ++c_) { \
        const bf16x8 v_ = (bf16x8){vf[c_][0][0], vf[c_][0][1], vf[c_][0][2], vf[c_][0][3], vf[c_][1][0], vf[c_][1][1], vf[c_][1][2], vf[c_][1][3]}; \
        o[c_] = __builtin_amdgcn_mfma_f32_32x32x16_bf16(v_, pfv, o[c_], 0, 0, 0); } } while (0)
#define ATT_PACK(p, i0) __builtin_bit_cast(bf16x8, (u32x4){cvt_pk_bf16(p[(i0)], p[(i0) + 1]), cvt_pk_bf16(p[(i0) + 2], p[(i0) + 3]), cvt_pk_bf16(p[(i0) + 4], p[(i0) + 5]), cvt_pk_bf16(p[(i0) + 6], p[(i0) + 7])})
    float ls = 0.f;
    s16x4 va[NC][2], vb2[NC][2];
    if constexpr (PIPE) {
    bf16x8 ka0 = ATT_LDK(0, 0), ka1 = ATT_LDK(1, 0), kb0 = ATT_LDK(0, 1), kb1 = ATT_LDK(1, 1), kc0, kc1;
    s16x4 vc2[NC][2];
    ATT_SB();
    kc0 = ATT_LDK(0, 2); kc1 = ATT_LDK(1, 2);
    n0 = __builtin_amdgcn_mfma_f32_32x32x16_bf16(ka0, qf[0], negm, 0, 0, 0); n1 = __builtin_amdgcn_mfma_f32_32x32x16_bf16(ka1, qf[0], negm, 0, 0, 0);
    ATT_EXP8(c0, 0);
    ATT_SB();
    ka0 = ATT_LDK(0, 3); ka1 = ATT_LDK(1, 3);
    n0 = __builtin_amdgcn_mfma_f32_32x32x16_bf16(kb0, qf[1], n0, 0, 0, 0); n1 = __builtin_amdgcn_mfma_f32_32x32x16_bf16(kb1, qf[1], n1, 0, 0, 0);
    ATT_EXP8(c0, 8);
    ATT_SB();
    ATT_LDV(va, 0);
    n0 = __builtin_amdgcn_mfma_f32_32x32x16_bf16(kc0, qf[2], n0, 0, 0, 0); n1 = __builtin_amdgcn_mfma_f32_32x32x16_bf16(kc1, qf[2], n1, 0, 0, 0);
    ATT_EXP8(c1, 0);
    ATT_SB();
    ATT_LDV(vb2, 1);
    n0 = __builtin_amdgcn_mfma_f32_32x32x16_bf16(ka0, qf[3], n0, 0, 0, 0); n1 = __builtin_amdgcn_mfma_f32_32x32x16_bf16(ka1, qf[3], n1, 0, 0, 0);
    ATT_EXP8(c1, 8);
    ATT_SB();
    l += ls;
    { const bf16x8 pf = ATT_PACK(c0, 0); ATT_LDV(vc2, 2); ATT_PV(va, pf); } ATT_SB();
    { const bf16x8 pf = ATT_PACK(c0, 8); ATT_LDV(va, 3); ATT_PV(vb2, pf); } ATT_SB();
    { const bf16x8 pf = ATT_PACK(c1, 0); ATT_PV(vc2, pf); } ATT_SB();
    { const bf16x8 pf = ATT_PACK(c1, 8); ATT_PV(va, pf); } ATT_SB();
    } else {
    ATT_LDV(va, 0); ATT_EXP8(c0, 0);
    ATT_SB();
    { const bf16x8 pf = ATT_PACK(c0, 0); ATT_LDV(vb2, 1); ATT_PV(va, pf); ATT_EXP8(c0, 8); } ATT_SB();
    { const bf16x8 pf = ATT_PACK(c0, 8); ATT_LDV(va, 2); ATT_PV(vb2, pf); ATT_EXP8(c1, 0); } ATT_SB();
    { const bf16x8 pf = ATT_PACK(c1, 0); ATT_LDV(vb2, 3); ATT_PV(va, pf); ATT_EXP8(c1, 8); } ATT_SB();
    { const bf16x8 pf = ATT_PACK(c1, 8); ATT_PV(vb2, pf); } ATT_SB();
    l += ls;
    }
#undef ATT_LDK
#undef ATT_EXP8
#undef ATT_LDV
#undef ATT_PV
#undef ATT_PACK
}
template <int DV, bool WINDOW, bool PIPE = true, int NK = 64>
__device__ __forceinline__ void attn_pass(ldsp_t lds, const bf16x8 (&qf)[4], const bf16_t* K, int kp, const bf16_t* V, int vp,
                                          int s0_row, int s0_tiles, int s1_row, int s1_tiles, int qpos, int s1_kpos0,
                                          f32x16 (&o)[DV / 32], float& m_out, float& l_out, int tid, int lane) {
    const int r = lane & 31, h = lane >> 5;
    const int nt = s0_tiles + s1_tiles;
#pragma unroll
    for (int c = 0; c < DV / 32; ++c)
#pragma unroll
        for (int i = 0; i < 16; ++i) o[c][i] = 0.f;
    float m, l = 0.f;
    const int koff0 = r * 128, koff1 = (32 + r) * 128, kx0 = (r >> 1) & 7, kx1 = ((32 + r) >> 1) & 7;
    const int i16 = lane & 15, q4 = i16 >> 2, p4 = i16 & 3, rhalf = (lane >> 4) & 1;
    const int voff = (4 * h + q4) * 64 + (16 * rhalf + 4 * p4) * 2;
    constexpr int SUB = NK / 64, KBB = NK * 128, VBB = NK * DV * 2, KR = (PIPE && SUB > 1) ? 3 : 2;
    const int ns = nt / SUB;
#define ATT_ROW(st) ((st) * SUB < s0_tiles ? s0_row + NK * (st) : s1_row + NK * ((st) - s0_tiles / SUB))
#define ATT_KB(b) (lds + (b) * KBB)
#define ATT_VB(b) (lds + KR * KBB + (b) * VBB)
    StK<NK> stk; StV<DV, NK> stv;
    load_k<NK>(stk, K, kp, ATT_ROW(0), tid); load_v<DV, NK>(stv, V, vp, ATT_ROW(0), tid); write_k<NK>(stk, ATT_KB(0), tid); write_v<DV, NK>(stv, ATT_VB(0), tid);
    if (PIPE && ns > 1) { load_k<NK>(stk, K, kp, ATT_ROW(1), tid); write_k<NK>(stk, ATT_KB(1), tid); }
    __syncthreads();
    f32x16 pA0, pA1, negm;
#pragma unroll
    for (int i = 0; i < 16; ++i) negm[i] = 0.f;
    qk(pA0, pA1, ATT_KB(0), qf, negm, koff0, koff1, kx0, kx1, h);
    { m = rowmax(pA0, pA1);
#pragma unroll
      for (int i = 0; i < 16; ++i) { pA0[i] -= m; pA1[i] -= m; negm[i] = -m; } }
    if constexpr (PIPE) {
    f32x16 pB0, pB1;
#define ATT_SUBT(c0, c1, n0, n1, st, j, par) do { const int t_ = (st) * SUB + (j); \
        sm_head<DV, WINDOW>(c0, c1, m, l, negm, o, t_ >= s0_tiles, s1_kpos0 + 64 * (t_ - s0_tiles), qpos, h); \
        fused_body<DV, true>(c0, c1, n0, n1, ((j) + 1 < SUB ? ATT_KB(kc) + ((j) + 1) * 8192 : ATT_KB(kn)), ATT_VB(par) + (j) * (DV * 128), qf, negm, o, l, koff0, koff1, kx0, kx1, h, voff); } while (0)
#define ATT_STEP(st, par) do { \
        const bool has1_ = (st) + 1 < ns, has2_ = (st) + 2 < ns; \
        const int kn = (kc + 1 == KR) ? 0 : kc + 1, kw = (kn + 1 == KR) ? 0 : kn + 1;     \
        if (has2_) load_k<NK>(stk, K, kp, ATT_ROW((st) + 2), tid); \
        if (has1_) load_v<DV, NK>(stv, V, vp, ATT_ROW((st) + 1), tid); \
        if constexpr (SUB == 1) { if ((par) == 0) ATT_SUBT(pA0, pA1, pB0, pB1, st, 0, par); else ATT_SUBT(pB0, pB1, pA0, pA1, st, 0, par); } \
        else { ATT_SUBT(pA0, pA1, pB0, pB1, st, 0, par); ATT_SUBT(pB0, pB1, pA0, pA1, st, 1, par); } \
        if (has2_) write_k<NK>(stk, ATT_KB(kw), tid); \
        if (has1_) write_v<DV, NK>(stv, ATT_VB(1 - (par)), tid); \
        __syncthreads(); kc = kn; } while (0)
    int kc = 0;
    for (int st = 0; st < ns; st += 2) {
        ATT_STEP(st, 0);
        if (st + 1 < ns) ATT_STEP(st + 1, 1);
    }
#undef ATT_SUBT
    } else {
#define ATT_STEP1(t, par) do { \
        const bool has1_ = (t) + 1 < nt; \
        if (has1_) { load_k<NK>(stk, K, kp, ATT_ROW((t) + 1), tid); load_v<DV, NK>(stv, V, vp, ATT_ROW((t) + 1), tid); } \
        if ((t) > 0) qk(pA0, pA1, ATT_KB(par), qf, negm, koff0, koff1, kx0, kx1, h); \
        sm_head<DV, WINDOW>(pA0, pA1, m, l, negm, o, (t) >= s0_tiles, s1_kpos0 + 64 * ((t) - s0_tiles), qpos, h); \
        fused_body<DV, false>(pA0, pA1, pA0, pA1, ATT_KB(par), ATT_VB(par), qf, negm, o, l, koff0, koff1, kx0, kx1, h, voff); \
        if (has1_) { write_k<NK>(stk, ATT_KB(1 - (par)), tid); write_v<DV, NK>(stv, ATT_VB(1 - (par)), tid); } \
        __syncthreads(); } while (0)
    static_assert(PIPE || NK == 64, "the unpipelined order walks 64-key steps");
    for (int t = 0; t < nt; t += 2) {
        ATT_STEP1(t, 0);
        if (t + 1 < nt) ATT_STEP1(t + 1, 1);
    }
#undef ATT_STEP1
    }
#undef ATT_STEP
#undef ATT_ROW
#undef ATT_KB
#undef ATT_VB
    m_out = m; { float la = l, lb = l; swap32(la, lb); l_out = la + lb; }
}
__device__ __forceinline__ void load_q(bf16x8 (&qf)[4], const bf16_t* Qrow, int h) {
#pragma unroll
    for (int s = 0; s < 4; ++s) qf[s] = *(const bf16x8*)(Qrow + 16 * s + 8 * h);
}
__device__ __forceinline__ void store_pair(bf16_t* Orow, int dvbase, f32x4 a0, f32x4 a1, int h) {
    u32x2 w0, w1; w0.x = cvt_pk_bf16(a0[0], a0[1]); w0.y = cvt_pk_bf16(a0[2], a0[3]); w1.x = cvt_pk_bf16(a1[0], a1[1]); w1.y = cvt_pk_bf16(a1[2], a1[3]);
    { auto rx = __builtin_amdgcn_permlane32_swap(w0.x, w1.x, false, false); w0.x = rx[0]; w1.x = rx[1]; auto ry = __builtin_amdgcn_permlane32_swap(w0.y, w1.y, false, false); w0.y = ry[0]; w1.y = ry[1]; }
    const u32x4 out = (u32x4){w0.x, w0.y, w1.x, w1.y}; (void)h;
    *(u32x4*)(Orow + dvbase + 8 * h) = out;
}
template <int DV> __device__ __forceinline__ void store_o(const f32x16 (&o)[DV / 32], float scale, bf16_t* Orow, int h) {
#pragma unroll
    for (int c = 0; c < DV / 32; ++c)
#pragma unroll
        for (int g = 0; g < 4; g += 2)
            store_pair(Orow, 32 * c + 8 * g, (f32x4){o[c][4 * g] * scale, o[c][4 * g + 1] * scale, o[c][4 * g + 2] * scale, o[c][4 * g + 3] * scale},
                       (f32x4){o[c][4 * g + 4] * scale, o[c][4 * g + 5] * scale, o[c][4 * g + 6] * scale, o[c][4 * g + 7] * scale}, h);
}
}

template <int PERMKIND> __device__ __forceinline__ int dest_row(int n) {
    if (PERMKIND == 1) { const int tile = n >> 8, nl = n & 255, wc = nl >> 6, bj = (nl >> 5) & 1, r5 = nl & 31; return (tile << 8) + 128 * bj + 32 * wc + r5; }
    if (PERMKIND == 2) { return n < 1024 ? (((n >> 7) << 8) + (n & 127)) : ((((n - 1024) >> 7) << 8) + 128 + ((n - 1024) & 127)); }
    return n;
}
template <int PERMKIND> __device__ __forceinline__ int dest_col(int n) {
    if (PERMKIND == 4) { const int tile = n >> 8, o = n & 255, wc = o >> 6, fq = (o >> 4) & 3, bj = (o >> 3) & 1, low3 = o & 7; return (tile << 8) + 128 * bj + 32 * wc + 8 * fq + low3; }
    return dest_row<PERMKIND>(n & ~31) + (n & 31);
}
template <int PERMKIND> __device__ __forceinline__ int r_off(int n0, int r) { return dest_row<PERMKIND>(n0 + (r & 32)) - dest_row<PERMKIND>(n0) + (r & 31); }
template <int PERMKIND> __device__ __forceinline__ void p0_transpose_item(const float* W, int K, int ldw, int n_src0, int N, bf16_t* WT, LAS float* scr, int item, int lane, int nperm = 0) {
    const int nblk = N / 32, kb = item / nblk, nb = item % nblk, k0 = 64 * kb, n0 = 32 * nb;
#pragma unroll 8
    for (int i = 0; i < 32; ++i) { const int kk = 2 * i + (lane >> 5); scr[kk * 33 + (lane & 31)] = W[(size_t)(k0 + kk) * ldw + n_src0 + n0 + (lane & 31)]; }
    LDS_WAIT(); asm volatile("" ::: "memory");
    const int c = lane & 7; const int dr0 = dest_row<PERMKIND>(n0);
#pragma unroll
    for (int j = 0; j < 4; ++j) { const int n = (lane >> 3) + 8 * j; const LAS float* s = scr + (8 * c) * 33 + n;
        u32x4 o; o.x = pk2(s[0 * 33], s[1 * 33]); o.y = pk2(s[2 * 33], s[3 * 33]); o.z = pk2(s[4 * 33], s[5 * 33]); o.w = pk2(s[6 * 33], s[7 * 33]);
        const int slot = (n0 < nperm) ? (8 * ((n >> 2) & 3) + 4 * (n >> 4) + (n & 3)) : n;
        *(u32x4*)(WT + (size_t)(dr0 + slot) * K + k0 + 8 * c) = o; }
    LDS_WAIT(); asm volatile("" ::: "memory");
}
template <int PERMKIND> __device__ __forceinline__ void t8_step(const float* W, int K, int N, unsigned char* WT8, float scale, LAS unsigned* scr, int k0, int n0, int lane) {
    float v[128];
    const float* wp = W + (size_t)k0 * N + n0 + lane;
#pragma unroll
    for (int i = 0; i < 128; ++i) v[i] = wp[(size_t)i * N];
#pragma unroll
    for (int g = 0; g < 32; ++g) scr[lane * 33 + g] = pk4_fp8(v[4 * g] * scale, v[4 * g + 1] * scale, v[4 * g + 2] * scale, v[4 * g + 3] * scale);
    LDS_WAIT(); asm volatile("" ::: "memory");
    const int q = lane & 7;
#pragma unroll
    for (int j = 0; j < 8; ++j) { const int r = (lane >> 3) + 8 * j; u32x4 o; o.x = scr[r * 33 + 4 * q]; o.y = scr[r * 33 + 4 * q + 1]; o.z = scr[r * 33 + 4 * q + 2]; o.w = scr[r * 33 + 4 * q + 3];
        *(u32x4*)(WT8 + (size_t)dest_col<PERMKIND>(n0 + r) * K + k0 + 16 * q) = o; }
    LDS_WAIT(); asm volatile("" ::: "memory");
}
template <int PERMKIND> __device__ __forceinline__ void t8_stream(const float* W, int nmat, int K, int N, int ksplit, unsigned char* WT8, float scale, LAS float* scrf, int gw, int NGW, int lane) {
    const int spm = (N / 64) * ksplit, total = nmat * spm, klen = K / ksplit;
    for (int st = gw; st < total; st += NGW) {
        const int mi = st / spm, r = st % spm, nb = r / ksplit, kh = r % ksplit;
        for (int k0 = kh * klen; k0 < (kh + 1) * klen; k0 += 128)
            t8_step<PERMKIND>(W + (size_t)mi * K * N, K, N, WT8 + (size_t)mi * K * N, scale, (LAS unsigned*)scrf, k0, 64 * nb, lane);
    }
}
__device__ __forceinline__ float silu(float x) { return x / (1.0f + __expf(-x)); }

__device__ __forceinline__ void p0_prologue(Frame& F, const KArgs& A) {
    const int gw = F.vcu * 8 + F.wave, NGW = F.G * 8;
    if (F.vcu >= 64 || F.G < 256) {
        const float* c = A.in(1); const float* cc = A.in(3); const float* mw = A.in(4); const float* mb = A.in(5);
        float* modv = WSP(float, WS_MODV);
        LAS float* red = (LAS float*)F.lds;
        LAS float* sl = (LAS float*)(F.lds + 16384);
        for (int i = F.tid; i < 5 * D; i += 512) sl[i] = silu(i < 4 * D ? c[i] : cc[i - 4 * D]);
        __syncthreads();
        const int first = F.G < 256 ? F.vcu : F.vcu - 64, step = F.G < 256 ? F.G : F.G - 64;
        for (int it = first; it < 2 * (NMOD / 64); it += step) {
            const int l = it / (NMOD / 64), col = (it % (NMOD / 64)) * 64 + F.lane;
            float a[5] = {0.f, 0.f, 0.f, 0.f, 0.f};
            const float* wp = mw + (size_t)l * D * NMOD + col;
#pragma unroll 16
            for (int k = F.wave * 128; k < F.wave * 128 + 128; ++k) {
                const float w = wp[(size_t)k * NMOD];
#pragma unroll
                for (int r = 0; r < 5; ++r) a[r] += sl[r * D + k] * w;
            }
#pragma unroll
            for (int r = 0; r < 5; ++r) red[(F.wave * 5 + r) * 64 + F.lane] = a[r];
            __syncthreads();
            if (F.wave < 5) { float s2 = mb[l * NMOD + col];
#pragma unroll
                for (int w = 0; w < 8; ++w) s2 += red[(w * 5 + F.wave) * 64 + F.lane];
                modv[((size_t)l * 5 + F.wave) * NMOD + col] = s2; }
            __syncthreads();
        }
    }
    if (gw < 16) { const int idx = gw * 64 + F.lane; const int pos = idx >> 4, f = idx & 15;
        const float inv = powf(10000.0f, -(float)f / 16.0f); const float ang = (float)pos * inv;
        WSP(float, WS_ROPE)[idx] = cosf(ang); WSP(float, WS_ROPE)[1024 + idx] = sinf(ang); }
    {
        bf16_t* A = WSP(bf16_t, WS_ADFT);
        for (int idx = gw * 64 + F.lane; idx < 17 * 256 * 256; idx += NGW * 64) {
            const int gi = idx >> 16, t2p = (idx >> 8) & 255, t2 = idx & 255;
            float cv, sv;
            if (gi < 16) { const int tp = gi + 16 * t2p; const int ph = (t2 * tp) & 4095; const float ang = (float)ph * (6.283185307179586f / 4096.0f); cv = cosf(ang) * (1.0f / 64.0f); sv = sinf(ang) * (1.0f / 64.0f); }
            else { const int ph = (t2 * t2p) & 255; const float ang = (float)ph * (6.283185307179586f / 256.0f); cv = cosf(ang) * (1.0f / 16.0f); sv = -sinf(ang) * (1.0f / 16.0f); }
            A[((size_t)gi * 256 + t2p) * 512 + t2] = (bf16_t)f2bf(cv); A[((size_t)gi * 256 + t2p) * 512 + 256 + t2] = (bf16_t)f2bf(sv);
        }
    }
    {
        const float* W = A.in(8); bf16_t* WF = WSP(bf16_t, WS_WF);
        const float cs = cosf((float)F.lane * (6.283185307179586f / 64.0f)), sn = sinf((float)F.lane * (6.283185307179586f / 64.0f));
        for (int it = gw; it < 4 * 128; it += NGW) {
            const int g = it >> 7, k0 = (it & 127) * 8;
            float ac[8], as[8];
#pragma unroll
            for (int kk = 0; kk < 8; ++kk) { ac[kk] = 0.f; as[kk] = 0.f; }
            float wv[8];
#pragma unroll
            for (int kk = 0; kk < 8; ++kk) wv[kk] = W[(size_t)(k0 + kk) * 1536 + 64 * g + F.lane];
            for (int c = 0; c < 64; ++c) {
                const int ph = (c * F.lane) & 63;
                const float cv = __shfl(cs, ph), sv = __shfl(sn, ph);
#pragma unroll
                for (int kk = 0; kk < 8; ++kk) { const float w = __shfl(wv[kk], c); ac[kk] += w * cv; as[kk] += w * sv; }
            }
            u32x4 oc, os;
            oc.x = pk2(ac[0] * 0.125f, ac[1] * 0.125f); oc.y = pk2(ac[2] * 0.125f, ac[3] * 0.125f); oc.z = pk2(ac[4] * 0.125f, ac[5] * 0.125f); oc.w = pk2(ac[6] * 0.125f, ac[7] * 0.125f);
            os.x = pk2(as[0] * 0.125f, as[1] * 0.125f); os.y = pk2(as[2] * 0.125f, as[3] * 0.125f); os.z = pk2(as[4] * 0.125f, as[5] * 0.125f); os.w = pk2(as[6] * 0.125f, as[7] * 0.125f);
            *(u32x4*)(WF + (size_t)(64 * g + F.lane) * D + k0) = oc;
            *(u32x4*)(WF + (size_t)(256 + 64 * g + F.lane) * D + k0) = os;
        }
    }
    {
        LAS float* scr = (LAS float*)(F.lds + F.wave * 16384);
        constexpr int I_ABI = 16 * 40, I_SQ = 16 * 32, I_CDI = 16 * 72, I_GU = 16 * 64, I_DN = 16 * 32;
        constexpr int NSMALL = I_ABI + I_SQ + I_CDI + I_SQ;
        for (int it = gw; it < NSMALL; it += NGW) {
            int r = it;
            if (r < I_ABI) { p0_transpose_item<1>(A.in(8), D, 1536, 256, 1280, WSP(bf16_t, WS_WABI), scr, r, F.lane, 1024); continue; } r -= I_ABI;
            if (r < I_SQ) { p0_transpose_item<1>(A.in(10), D, D, 0, D, WSP(bf16_t, WS_WABO), scr, r, F.lane); continue; } r -= I_SQ;
            if (r < I_CDI) { p0_transpose_item<1>(A.in(11), D, CD_N, 0, CD_N, WSP(bf16_t, WS_WCDI), scr, r, F.lane, 1664); continue; } r -= I_CDI;
            p0_transpose_item<1>(A.in(16), D, D, 0, D, WSP(bf16_t, WS_WCDO), scr, r, F.lane);
        }
        t8_stream<2>(A.in(19), 32, D, 2048, 2, WSP(unsigned char, WS_WGU), WGU_SCALE, scr, gw, NGW, F.lane);
        t8_stream<4>(A.in(21), 32, FF, D, 4, WSP(unsigned char, WS_WD), WD_SCALE, scr, gw, NGW, F.lane);
    }
}

constexpr int BG_GU = 32 * 32 * 8, BG_DN = 32 * 16 * 8, BG_TOTAL = BG_GU + BG_DN;
constexpr int BG_P2 = 0, BG_P5 = BG_P2 + 36 * 8 * 3, BG_P11 = BG_P5 + 240 * 8 * 2, BG_P9 = BG_P11 + 156 * 8 * 3;
__device__ __forceinline__ void bg_step(Frame& F, const KArgs& A, int s) {
    LAS unsigned* scr = (LAS unsigned*)(F.lds + F.wave * 16384);
    if (s < BG_GU) { const int mi = 32 + (s >> 8), k0 = ((s >> 5) & 7) * 128, nb = s & 31;
        t8_step<2>(A.in(19) + (size_t)mi * D * 2048, D, 2048, WSP(unsigned char, WS_WGU) + (size_t)mi * D * 2048, WGU_SCALE, scr, k0, 64 * nb, F.lane); }
    else { const int q = s - BG_GU; const int mi = 32 + (q >> 7), k0 = ((q >> 4) & 7) * 128, nb = q & 15;
        t8_step<4>(A.in(21) + (size_t)mi * FF * D, FF, D, WSP(unsigned char, WS_WD) + (size_t)mi * FF * D, WD_SCALE, scr, k0, 64 * nb, F.lane); }
}
__device__ __forceinline__ void bg_range(Frame& F, const KArgs& A, int base, int first_vcu, int n) {
    const int s0 = base + ((F.vcu - first_vcu) * 8 + F.wave) * n;
    for (int i = 0; i < n; ++i) if (s0 + i < BG_TOTAL) bg_step(F, A, s0 + i);
}
__device__ __forceinline__ int bg_moe_idle(int T1, int nN, int G) { const int rem = (T1 * nN) % G; return rem; }

__device__ __forceinline__ void ld_row(f32x4 (&v)[4], const float* p, int lane) {
#pragma unroll
    for (int j = 0; j < 4; ++j) v[j] = *((const f32x4*)p + lane + 64 * j);
}
__device__ __forceinline__ void ld_row_bf16(f32x4 (&v)[4], const bf16_t* p, int lane) {
#pragma unroll
    for (int j = 0; j < 4; ++j) { const u32x2 w = *((const u32x2*)p + lane + 64 * j); v[j] = (f32x4){bf2f(w.x & 0xffffu), bf2f(w.x >> 16), bf2f(w.y & 0xffffu), bf2f(w.y >> 16)}; }
}
__device__ __forceinline__ void st_row(float* p, const f32x4 (&v)[4], int lane) {
#pragma unroll
    for (int j = 0; j < 4; ++j) *((f32x4*)p + lane + 64 * j) = v[j];
}
__device__ __forceinline__ void st_row_bf16(bf16_t* p, const f32x4 (&v)[4], int lane) {
#pragma unroll
    for (int j = 0; j < 4; ++j) { u32x2 w; w.x = pk2(v[j][0], v[j][1]); w.y = pk2(v[j][2], v[j][3]); *((u32x2*)p + lane + 64 * j) = w; }
}
__device__ __forceinline__ void st_row_fp8(unsigned char* p, const f32x4 (&v)[4], int lane) {
#pragma unroll
    for (int j = 0; j < 4; ++j) *((unsigned*)p + lane + 64 * j) = pk4_fp8(v[j][0], v[j][1], v[j][2], v[j][3]);
}
__device__ __forceinline__ void layernorm_row(f32x4 (&v)[4], const float* g, const float* b, int lane) {
    float s = 0.f;
#pragma unroll
    for (int j = 0; j < 4; ++j) s += (v[j][0] + v[j][1]) + (v[j][2] + v[j][3]);
    const float mean = wave_sum(s) * (1.0f / D); float s2 = 0.f;
#pragma unroll
    for (int j = 0; j < 4; ++j) { v[j] = v[j] - mean; s2 += (v[j][0] * v[j][0] + v[j][1] * v[j][1]) + (v[j][2] * v[j][2] + v[j][3] * v[j][3]); }
    const float rstd = 1.0f / sqrtf(wave_sum(s2) * (1.0f / D) + LN_EPS);
    f32x4 gg[4], bb[4]; ld_row(gg, g, lane); ld_row(bb, b, lane);
#pragma unroll
    for (int j = 0; j < 4; ++j) v[j] = v[j] * rstd * gg[j] + bb[j];
}
__device__ __forceinline__ int row_bi(int row) { return row < NCTX ? 4 : ((row - NCTX) >> 12); }
__device__ __forceinline__ const float* x_in_row(const KArgs& A, int row) { return row < NCTX ? A.in(2) + (size_t)row * D : A.in(0) + (size_t)(row - NCTX) * D; }

__device__ __forceinline__ void p_modulate0(Frame& F, const KArgs& A) {
    const int gw = F.vcu * 8 + F.wave, NGW = F.G * 8;
    const float* modv = WSP(float, WS_MODV); bf16_t* H = WSP(bf16_t, WS_H);
    for (int row = gw; row < NROW; row += NGW) {
        const float* mv = modv + (size_t)row_bi(row) * NMOD;
        f32x4 x[4], sh[4], sc[4]; ld_row(x, x_in_row(A, row), F.lane); ld_row(sh, mv, F.lane); ld_row(sc, mv + D, F.lane);
#pragma unroll
        for (int j = 0; j < 4; ++j) x[j] = x[j] * (1.0f + sc[j]) + sh[j];
        st_row_bf16(H + (size_t)row * D, x, F.lane);
    }
}

__device__ __forceinline__ void p_fourier1(Frame& F) {
    constexpr float C16[16] = {1.0f, 0.92387953251f, 0.70710678119f, 0.38268343237f, 0.0f, -0.38268343237f, -0.70710678119f, -0.92387953251f, -1.0f, -0.92387953251f, -0.70710678119f, -0.38268343237f, 0.0f, 0.38268343237f, 0.70710678119f, 0.92387953251f};
    const bf16_t* GT = WSP(bf16_t, WS_GT); bf16_t* YF = WSP(bf16_t, WS_YF);
    const int nthreads = F.G * 512;
    for (int idx = F.vcu * 512 + F.tid; idx < 4 * 256 * 256; idx += nthreads) {
        const int bc = idx >> 8, t2 = idx & 255;
        float gc[16], gs[16];
#pragma unroll
        for (int t1 = 0; t1 < 16; ++t1) { gc[t1] = bf2f(GT[((size_t)bc * 2 + 0) * SEQ + 256 * t1 + t2]); gs[t1] = bf2f(GT[((size_t)bc * 2 + 1) * SEQ + 256 * t1 + t2]); }
#pragma unroll
        for (int tp = 0; tp < 16; ++tp) { float yr = 0.f, yi = 0.f;
#pragma unroll
            for (int t1 = 0; t1 < 16; ++t1) { const float cv = C16[(t1 * tp) & 15], sv = C16[((t1 * tp) + 12) & 15];
                yr += gc[t1] * cv - gs[t1] * sv; yi -= gc[t1] * sv + gs[t1] * cv; }
            YF[((size_t)tp * 1024 + bc) * 512 + t2] = (bf16_t)f2bf(yr); YF[((size_t)tp * 1024 + bc) * 512 + 256 + t2] = (bf16_t)f2bf(yi); }
    }
}

__device__ __forceinline__ void p_attn0(Frame& F, const KArgs& A) {
    const bf16_t* P = WSP(bf16_t, WS_PB); bf16_t* O = WSP(bf16_t, WS_O); const float* sink = A.in(9);
    const int r = F.lane & 31, h = F.lane >> 5;
    constexpr int NU_LAT = BATCH * 12 * 16, NU = NU_LAT + BATCH * 12;
    for (int u = F.vcu; u < NU; u += F.G) {
        int b, qh, qrow0, s1_row, s1_tiles, kpos0, qpos0;
        const bool lat = u < NU_LAT;
        if (lat) { const int i = u & 15; qh = (u >> 4) % 12; b = u / 192; qpos0 = 256 * i; qrow0 = NCTX + b * SEQ + qpos0;
            const int lo = qpos0 - 128 < 0 ? 0 : qpos0 - 128, hi = qpos0 + 384 > SEQ ? SEQ : qpos0 + 384; kpos0 = lo; s1_row = NCTX + b * SEQ + lo; s1_tiles = (hi - lo) >> 6; }
        else { const int v = u - NU_LAT; qh = v % 12; b = v / 12; qrow0 = b * CTXL; qpos0 = 0; s1_row = 0; s1_tiles = 0; kpos0 = 0; }
        const int kvh = qh / 3;
        bf16x8 qf[4]; att::load_q(qf, P + (size_t)(qrow0 + 32 * F.wave + r) * AB_N + 64 * qh, h);
        f32x16 o[2]; float m, l;
        const int wq0 = qpos0 + 32 * F.wave;
        if (lat) att::attn_pass<64, true, true, 128>(F.lds, qf, P + 768 + 64 * kvh, AB_N, P + 1024 + 64 * kvh, AB_N, b * CTXL, 4, s1_row, s1_tiles, wq0 + r, kpos0, o, m, l, F.tid, F.lane);
        else att::attn_pass<64, false, true, 128>(F.lds, qf, P + 768 + 64 * kvh, AB_N, P + 1024 + 64 * kvh, AB_N, b * CTXL, 4, 0, 0, 0, 0, o, m, l, F.tid, F.lane);
        const float sl = sink[qh] * LOG2E; const float m2 = fmaxf(m, sl), a = __builtin_amdgcn_exp2f(m - m2);
        const float lt = l * a + __builtin_amdgcn_exp2f(sl - m2);
        att::store_o<64>(o, a / lt, O + (size_t)(qrow0 + 32 * F.wave + r) * D + 256 + 64 * qh, h);
    }
}
__device__ __forceinline__ void p_attn1(Frame& F, const KArgs& A) {
    const bf16_t* P = WSP(bf16_t, WS_PB); bf16_t* O = WSP(bf16_t, WS_O);
    const int r = F.lane & 31, h = F.lane >> 5;
    float lam;
    { const float* lv = A.in(12); const float a = wave_sum(lv[F.lane] * lv[64 + F.lane]), b2 = wave_sum(lv[128 + F.lane] * lv[192 + F.lane]); lam = expf(a) - expf(b2) + LAMBDA_INIT1; }
    constexpr int NU_C = BATCH * 4 * 16, NU_D = BATCH * 8 * 16;
#ifndef ATTN_PROBE
#define ATTN_PROBE 0
#endif
    for (int rep_ = 0; rep_ < (ATTN_PROBE == 2 ? 2 : 1); ++rep_)
    for (int u = F.vcu; u < NU_C; u += F.G) {
        const int i = u & 15, c = (u >> 4) & 3, b = u >> 6;
        const int qrow = NCTX + b * SEQ + 256 * i + 32 * F.wave + r;
        const bf16_t* V = P + 1664 + 128 * c;
        f32x16 o2[4]; float m, l; bf16x8 qf[4];
        LAS unsigned* o1s = (LAS unsigned*)(F.lds + 49152) + F.wave * 2048 + F.lane;
        att::load_q(qf, P + (size_t)qrow * CD_N + 128 * c, h);
        att::attn_pass<128, false, false>(F.lds, qf, P + 1024 + 128 * c, CD_N, V, CD_N, b * CTXL, 4, NCTX + b * SEQ, 64, 0, 0, o2, m, l, F.tid, F.lane);
        { const float inv = 1.0f / l;
#pragma unroll
            for (int cc = 0; cc < 4; ++cc)
#pragma unroll
                for (int k = 0; k < 8; ++k) o1s[(cc * 8 + k) * 64] = cvt_pk_bf16(o2[cc][2 * k] * inv, o2[cc][2 * k + 1] * inv); }
        att::load_q(qf, P + (size_t)qrow * CD_N + 128 * c + 64, h);
        att::attn_pass<128, false, false>(F.lds, qf, P + 1024 + 128 * c + 64, CD_N, V, CD_N, b * CTXL, 4, NCTX + b * SEQ, 64, 0, 0, o2, m, l, F.tid, F.lane);
        { const float inv = lam / l; float ss = 0.f;
#pragma unroll
            for (int cc = 0; cc < 4; ++cc)
#pragma unroll
                for (int k = 0; k < 8; ++k) { const unsigned w = o1s[(cc * 8 + k) * 64];
                    const float v0 = bf2f(w & 0xffffu) - inv * o2[cc][2 * k], v1 = bf2f(w >> 16) - inv * o2[cc][2 * k + 1]; o2[cc][2 * k] = v0; o2[cc][2 * k + 1] = v1; ss += v0 * v0 + v1 * v1; }
            { float sa = ss, sb = ss; swap32(sa, sb); ss = sa + sb; }
            const float rs = (1.0f - LAMBDA_INIT1) / sqrtf(ss * (1.0f / 128.0f) + RMS_EPS);
            const float* sg = A.in(13);
            bf16_t* Orow = O + (size_t)qrow * D + 128 * c;
#pragma unroll
            for (int cc = 0; cc < 4; ++cc)
#pragma unroll
                for (int g = 0; g < 4; g += 2) { const int dv = 32 * cc + 8 * g + 4 * h; const f32x4 g0 = *(const f32x4*)(sg + dv), g1 = *(const f32x4*)(sg + dv + 8);
                    att::store_pair(Orow, 32 * cc + 8 * g, (f32x4){o2[cc][4 * g] * rs * g0[0], o2[cc][4 * g + 1] * rs * g0[1], o2[cc][4 * g + 2] * rs * g0[2], o2[cc][4 * g + 3] * rs * g0[3]},
                                    (f32x4){o2[cc][4 * g + 4] * rs * g1[0], o2[cc][4 * g + 5] * rs * g1[1], o2[cc][4 * g + 6] * rs * g1[2], o2[cc][4 * g + 7] * rs * g1[3]}, h); }
        }
    }
    for (int rep_ = 0; rep_ < (ATTN_PROBE == 1 ? 2 : 1); ++rep_)
    for (int u = F.vcu; u < NU_D; u += F.G) {
        const int i = u & 15, qh = (u >> 4) & 7, b = u >> 7, kvh = qh >> 2;
        const int qrow = NCTX + b * SEQ + 256 * i + 32 * F.wave + r;
        f32x16 o[2]; float m, l; bf16x8 qf[4];
        att::load_q(qf, P + (size_t)qrow * CD_N + 512 + 64 * qh, h);
        att::attn_pass<64, false, true, 128>(F.lds, qf, P + 1536 + 64 * kvh, CD_N, P + 2176 + 64 * kvh, CD_N, b * CTXL, 4, NCTX + b * SEQ, 64, 0, 0, o, m, l, F.tid, F.lane);
        att::store_o<64>(o, 1.0f / l, O + (size_t)qrow * D + 512 + 64 * qh, h);
    }
}

__device__ __forceinline__ XcdBarrier frame_barrier(const Frame& F) { XcdBarrier b; b.bar = (unsigned*)(F.ws + WS_CTL) + CW_BAR; b.x = xb_xcc_id(); b.st = (volatile LAS unsigned*)(F.lds + MISC_OFF) + 8; return b; }
template <int L> __device__ __forceinline__ void p_rows1(Frame& F, const KArgs& A, int cw_off = 0, bool seam_wait = false) {
    const int row_lo = L == 0 ? 0 : NCTX;
    const int gw = F.vcu * 8 + F.wave, NGW = F.G * 8;
    LAS float* wt = (LAS float*)F.lds;
    LAS int* cntB = (LAS int*)(F.lds + LTAB_OFF);
    LAS int* baseB = cntB + 32;
    LAS int* lst = cntB + 64;
    { const float* rw = A.in(17) + (size_t)L * D * NE;
      const int e = F.tid & 31, dq = F.tid >> 5;
#pragma unroll 4
      for (int it = 0; it < 16; ++it) { const int d4 = dq + 16 * it; f32x4 w;
#pragma unroll
          for (int c = 0; c < 4; ++c) w[c] = rw[(size_t)(4 * d4 + c) * NE + e];
          *((LAS f32x4*)(wt + e * D) + (d4 ^ (e & 15))) = w; }
      if (F.tid < 32) cntB[F.tid] = 0; }
    if (seam_wait) { const XcdBarrier b_ = frame_barrier(F); xcd_wait(b_); } else __syncthreads();
    const float* modv = WSP(float, WS_MODV) + (size_t)L * 5 * NMOD;
    const bf16_t* Y = WSP(bf16_t, WS_Y); bf16_t* X1 = WSP(bf16_t, WS_X1); unsigned char* H8 = WSP(unsigned char, WS_H);
    const float* lng = A.in(6) + (size_t)(L * 2 + 0) * D; const float* lnb = A.in(7) + (size_t)(L * 2 + 0) * D;
    const float rbl = (A.in(18) + L * NE)[F.lane >> 1];
    int* tope = WSP(int, WS_TOPE); float* gate = WSP(float, WS_GATE); int* posb = WSP(int, WS_POS);
    int it = 0;
    f32x4 xn[2][4]; u32x2 xq[2][4], yn[2][4];
#define RW_FETCH(ROW0) do { _Pragma("unroll") for (int r = 0; r < 2; ++r) { const int row_ = (r == 0 || (ROW0) + NGW < NROW) ? (ROW0) + r * NGW : (ROW0); \
        if constexpr (L == 0) ld_row(xn[r], x_in_row(A, row_), F.lane); else { _Pragma("unroll") for (int j = 0; j < 4; ++j) xq[r][j] = *((const u32x2*)(WSP(bf16_t, WS_XR) + (size_t)row_ * D) + F.lane + 64 * j); } \
        _Pragma("unroll") for (int j = 0; j < 4; ++j) yn[r][j] = *((const u32x2*)(Y + (size_t)row_ * D) + F.lane + 64 * j); } } while (0)
    if (row_lo + gw < NROW) RW_FETCH(row_lo + gw);
    for (int row0 = row_lo + gw; row0 < NROW; row0 += 2 * NGW, it += 2) {
        const bool has2 = row0 + NGW < NROW;
        const int rows[2] = {row0, has2 ? row0 + NGW : row0};
        f32x4 v[2][4];
        { f32x4 g1[2][4];
#pragma unroll
          for (int r = 0; r < 2; ++r) { const float* mv = modv + (size_t)row_bi(rows[r]) * NMOD; ld_row(g1[r], mv + 2 * D, F.lane); }
#pragma unroll
          for (int r = 0; r < 2; ++r)
#pragma unroll
              for (int j = 0; j < 4; ++j) { const u32x2 w = yn[r][j]; f32x4 xv; if constexpr (L == 0) xv = xn[r][j]; else { const u32x2 q = xq[r][j]; xv = (f32x4){bf2f(q.x & 0xffffu), bf2f(q.x >> 16), bf2f(q.y & 0xffffu), bf2f(q.y >> 16)}; }
                  v[r][j] = DN_ALPHA * xv + g1[r][j] * (f32x4){bf2f(w.x & 0xffffu), bf2f(w.x >> 16), bf2f(w.y & 0xffffu), bf2f(w.y >> 16)}; } }
        { float s[2], s2[2];
#pragma unroll
          for (int r = 0; r < 2; ++r) { s[r] = 0.f;
#pragma unroll
              for (int j = 0; j < 4; ++j) s[r] += (v[r][j][0] + v[r][j][1]) + (v[r][j][2] + v[r][j][3]); }
#pragma unroll
          for (int r = 0; r < 2; ++r) s[r] = wave_sum(s[r]) * (1.0f / D);
#pragma unroll
          for (int r = 0; r < 2; ++r) { s2[r] = 0.f;
#pragma unroll
              for (int j = 0; j < 4; ++j) { v[r][j] = v[r][j] - s[r]; s2[r] += (v[r][j][0] * v[r][j][0] + v[r][j][1] * v[r][j][1]) + (v[r][j][2] * v[r][j][2] + v[r][j][3] * v[r][j][3]); } }
#pragma unroll
          for (int r = 0; r < 2; ++r) s2[r] = 1.0f / sqrtf(wave_sum(s2[r]) * (1.0f / D) + LN_EPS);
          f32x4 lg[4], lb[4]; ld_row(lg, lng, F.lane); ld_row(lb, lnb, F.lane);
#pragma unroll
          for (int r = 0; r < 2; ++r)
#pragma unroll
              for (int j = 0; j < 4; ++j) v[r][j] = v[r][j] * s2[r] * lg[j] + lb[j]; }
#pragma unroll
        for (int r = 0; r < 2; ++r) { const int row = rows[r]; const float* mv = modv + (size_t)row_bi(row) * NMOD;
            if (r == 0 || has2) st_row_bf16(X1 + (size_t)row * D, v[r], F.lane);
            f32x4 sh[4], sc[4]; ld_row(sh, mv + 3 * D, F.lane); ld_row(sc, mv + 4 * D, F.lane);
#pragma unroll
            for (int j = 0; j < 4; ++j) v[r][j] = v[r][j] * (1.0f + sc[j]) + sh[j];
            if (r == 0 || has2) st_row_fp8(H8 + (size_t)row * D, v[r], F.lane); }
        if (row0 + 2 * NGW < NROW) RW_FETCH(row0 + 2 * NGW);
        float part[2][8];
        {
#define RW_READ(W, G) do { _Pragma("unroll") for (int ee = 0; ee < 2; ++ee) { const int k_ = 2 * (G) + ee, E_ = ((k_ & 1) << 4) | ((k_ & 2) << 2) | (k_ & 4) | ((k_ & 8) >> 2) | ((k_ & 16) >> 4); \
            _Pragma("unroll") for (int j = 0; j < 4; ++j) W[ee * 4 + j] = *((const LAS f32x4*)(wt + E_ * D) + ((F.lane ^ (E_ & 15)) + 64 * j)); } } while (0)
          f32x4 wa[8], wb[8]; float l1prev[2] = {0.f, 0.f};
          RW_READ(wa, 0);
#pragma unroll
          for (int g = 0; g < 16; ++g) {
              if (g + 1 < 16) { if (g & 1) RW_READ(wa, g + 1); else RW_READ(wb, g + 1); }
              __builtin_amdgcn_sched_barrier(0);
              float pk[2][2];
#pragma unroll
              for (int ee = 0; ee < 2; ++ee) { f32x2 s0 = (f32x2){0.f, 0.f}, s1 = (f32x2){0.f, 0.f};
#pragma unroll
                  for (int j = 0; j < 4; ++j) { const f32x4 w = (g & 1) ? wb[ee * 4 + j] : wa[ee * 4 + j];
                      s0 = (f32x2){w[0], w[1]} * (f32x2){v[0][j][0], v[0][j][1]} + s0; s0 = (f32x2){w[2], w[3]} * (f32x2){v[0][j][2], v[0][j][3]} + s0;
                      s1 = (f32x2){w[0], w[1]} * (f32x2){v[1][j][0], v[1][j][1]} + s1; s1 = (f32x2){w[2], w[3]} * (f32x2){v[1][j][2], v[1][j][3]} + s1; }
                  pk[0][ee] = s0.x + s0.y; pk[1][ee] = s1.x + s1.y; }
#pragma unroll
              for (int r = 0; r < 2; ++r) { float a = pk[r][0], b2 = pk[r][1]; swap32(a, b2); const float l1 = a + b2;
                  if (g & 1) { float c = l1prev[r], d2 = l1; swap16(c, d2); part[r][g >> 1] = c + d2; } else l1prev[r] = l1; }
              __builtin_amdgcn_sched_barrier(0);
          }
#undef RW_READ
        }
#pragma unroll
        for (int r = 0; r < 2; ++r) { float (&pt)[8] = part[r];
            { const bool up = (F.lane >> 3) & 1;
#pragma unroll
              for (int i = 0; i < 4; ++i) { const float a = pt[2 * i], b2 = pt[2 * i + 1]; pt[i] = (up ? b2 : a) + dppf<DPP_XOR8>(up ? a : b2); } }
            { const bool up = (F.lane >> 2) & 1;
#pragma unroll
              for (int i = 0; i < 2; ++i) { const float a = pt[2 * i], b2 = pt[2 * i + 1]; pt[i] = (up ? b2 : a) + dppf<DPP_XOR7>(dppf<DPP_XOR3>(up ? a : b2)); } }
            { const bool up = (F.lane >> 1) & 1; const float a = pt[0], b2 = pt[1]; pt[0] = (up ? b2 : a) + dppf<DPP_XOR2>(up ? a : b2); } }
#pragma unroll
        for (int r = 0; r < 2; ++r) { const int row = rows[r];
            const float logit = part[r][0] + dppf<DPP_XOR1>(part[r][0]) + rbl;
            int key = __builtin_bit_cast(int, logit); key ^= (key >> 31) & 0x7fffffff;
            int te[4]; float tv[4];
#pragma unroll
            for (int k = 0; k < 4; ++k) { int m = key;
                m = max(m, dppi<DPP_XOR2>(m)); m = max(m, dppi<DPP_XOR7>(m)); m = max(m, dppi<DPP_XOR15>(m));
                { auto q = __builtin_amdgcn_permlane16_swap((unsigned)m, (unsigned)m, false, false); m = max((int)q[0], (int)q[1]); }
                { auto q = __builtin_amdgcn_permlane32_swap((unsigned)m, (unsigned)m, false, false); m = max((int)q[0], (int)q[1]); }
                const int e = (int)(__builtin_ctzll(__ballot(key == m)) >> 1);
                te[k] = e; tv[k] = __builtin_bit_cast(float, m ^ ((m >> 31) & 0x7fffffff)); if ((F.lane >> 1) == e) key = (int)0x80000000; }
            const float e1 = __expf(tv[1] - tv[0]), e2 = __expf(tv[2] - tv[0]), e3 = __expf(tv[3] - tv[0]); const float inv = 1.0f / (1.0f + e1 + e2 + e3);
            if (F.lane < 4 && (r == 0 || has2)) { const int k = F.lane; const int e = k == 0 ? te[0] : k == 1 ? te[1] : k == 2 ? te[2] : te[3]; const float gk = (k == 0 ? 1.0f : k == 1 ? e1 : k == 2 ? e2 : e3) * inv;
                tope[(size_t)row * 4 + k] = e; gate[(size_t)row * 4 + k] = gk;
                const int lp = __hip_atomic_fetch_add(cntB + e, 1, __ATOMIC_RELAXED, __HIP_MEMORY_SCOPE_WORKGROUP);
                lst[(F.wave * 12 + it + r) * 4 + k] = (e << 20) | lp; } }
    }
#undef RW_FETCH
    __syncthreads();
    if (F.tid < 32) baseB[F.tid] = (int)__hip_atomic_fetch_add((unsigned*)(F.ws + WS_CTL) + CW_CNT + 64 * L + cw_off + F.tid, (unsigned)cntB[F.tid], RLX_AGENT);
    __syncthreads();
    unsigned char* XGE = WSP(unsigned char, WS_XGE);
    it = 0;
    for (int row0 = row_lo + gw; row0 < NROW; row0 += 5 * NGW, it += 5) {
        u32x4 a[5]; int pos[5][4], ex[5][4];
#pragma unroll
        for (int r = 0; r < 5; ++r) { const int row = row0 + r * NGW;
            if (row < NROW) { a[r] = *((const u32x4*)(H8 + (size_t)row * D) + F.lane);
#pragma unroll
                for (int k = 0; k < 4; ++k) { const int pk = __builtin_amdgcn_readfirstlane(lst[(F.wave * 12 + it + r) * 4 + k]); ex[r][k] = pk >> 20; pos[r][k] = __builtin_amdgcn_readfirstlane(baseB[pk >> 20]) + (pk & 0xFFFFF); } } }
#pragma unroll
        for (int r = 0; r < 5; ++r) { const int row = row0 + r * NGW;
            if (row < NROW) {
#pragma unroll
                for (int k = 0; k < 4; ++k) *((u32x4*)(XGE + ((size_t)ex[r][k] * CAPR + pos[r][k]) * D) + F.lane) = a[r];
                if (F.lane < 4) posb[(size_t)row * 4 + F.lane] = F.lane == 0 ? pos[r][0] : F.lane == 1 ? pos[r][1] : F.lane == 2 ? pos[r][2] : pos[r][3]; } }
    }
}
__device__ __forceinline__ int expert_offsets(Frame& F, int L, int& cnt_out, int& total) {
    const int c = (int)__hip_atomic_load((unsigned*)(F.ws + WS_CTL) + CW_CNT + 64 * L + (F.lane & 31), RLX_AGENT);
    const int pad = (c + 255) & ~255; int incl = pad;
#pragma unroll
    for (int o = 1; o < 32; o <<= 1) { const int t = __shfl_up(incl, o); if ((F.lane & 31) >= o) incl += t; }
    total = __shfl(incl, 31); cnt_out = c; return incl - pad;
}
template <int L> __device__ __forceinline__ void p_gather(Frame& F, const KArgs& A) {
    const int row_lo = L == 0 ? 0 : NCTX;
    const int gw = F.vcu * 8 + F.wave, NGW = F.G * 8;
    int cnt, total; const int offs = expert_offsets(F, L, cnt, total);
    const unsigned char* H8 = WSP(unsigned char, WS_H); unsigned char* XG = WSP(unsigned char, WS_XG);
    const int* tope = WSP(int, WS_TOPE); const int* posb = WSP(int, WS_POS); int* slot = WSP(int, WS_SLOT);
    for (int row0 = row_lo + gw; row0 < NROW; row0 += 5 * NGW) {
        u32x4 a[5]; int sl[5][4];
#pragma unroll
        for (int r = 0; r < 5; ++r) { const int row = row0 + r * NGW;
            if (row < NROW) { a[r] = *((const u32x4*)(H8 + (size_t)row * D) + F.lane);
#pragma unroll
                for (int k = 0; k < 4; ++k) { const int e = __builtin_amdgcn_readfirstlane(tope[(size_t)row * 4 + k]); sl[r][k] = __builtin_amdgcn_readlane(offs, e) + __builtin_amdgcn_readfirstlane(posb[(size_t)row * 4 + k]); } } }
#pragma unroll
        for (int r = 0; r < 5; ++r) { const int row = row0 + r * NGW;
            if (row < NROW) {
#pragma unroll
                for (int k = 0; k < 4; ++k) *((u32x4*)(XG + (size_t)sl[r][k] * D) + F.lane) = a[r];
                if (F.lane < 4) slot[(size_t)row * 4 + F.lane] = F.lane == 0 ? sl[r][0] : F.lane == 1 ? sl[r][1] : F.lane == 2 ? sl[r][2] : sl[r][3]; } }
    }
    if (gw < 256) { const int e = gw >> 3; const int o = __shfl(offs, e), c = __shfl(cnt, e); const int pad = (c + 255) & ~255;
        for (int rr = o + c + (gw & 7); rr < o + pad; rr += 8) *((u32x4*)(XG + (size_t)rr * D) + F.lane) = (u32x4){0u, 0u, 0u, 0u}; }
}
__device__ __forceinline__ void build_tile_table(Frame& F, int L, LAS int* tile_e) {
    int cnt, total; const int offs = expert_offsets(F, L, cnt, total);
    if (F.wave == 0 && F.lane < 32) { const int t0 = offs >> 8, n = ((cnt + 255) & ~255) >> 8; for (int t = 0; t < n; ++t) tile_e[t0 + t] = F.lane; tile_e[320 + F.lane] = t0; if (F.lane == 0) tile_e[320 + 32] = total >> 8; }
    __syncthreads();
}
__device__ __forceinline__ MoeOrder moe_order(Frame& F, const LAS int* tile_e, int nN, const void* A, size_t a_tile, const void* B, size_t b_tile, size_t b_exp, int a_cap = 0) {
    MoeOrder S; (void)0;
    S.nN = nN; S.per = F.G; S.j = F.vcu; S.tile_e = tile_e; S.A = (const char*)A; S.B = (const char*)B; S.a_tile = a_tile; S.b_tile = b_tile; S.b_exp = b_exp;
    S.T0 = 0; S.T1 = __builtin_amdgcn_readfirstlane(tile_e[320 + 32]); S.a_cap = a_cap;
    return S;
}
template <int L> __device__ __forceinline__ void p_rows2(Frame& F, const KArgs& A) {
    const int row_lo = L == 0 ? 0 : NCTX;
    const int gw = F.vcu * 8 + F.wave, NGW = F.G * 8;
    const float* modv = WSP(float, WS_MODV) + (size_t)L * 5 * NMOD;
    const bf16_t* X1 = WSP(bf16_t, WS_X1); const unsigned char* YB = WSP(unsigned char, WS_XG);
    const float* lng = A.in(6) + (size_t)(L * 2 + 1) * D; const float* lnb = A.in(7) + (size_t)(L * 2 + 1) * D;
    const int* tope = WSP(int, WS_TOPE); const int* posb = WSP(int, WS_POS); const float* gate = WSP(float, WS_GATE);
    int cnt_, total_; const int offs = expert_offsets(F, L, cnt_, total_);
    for (int row = row_lo + gw; row < NROW; row += NGW) {
        const float* mv = modv + (size_t)row_bi(row) * NMOD;
        f32x4 f[4];
#pragma unroll
        for (int j = 0; j < 4; ++j) f[j] = (f32x4){0.f, 0.f, 0.f, 0.f};
#pragma unroll
        for (int k = 0; k < 4; ++k) { const int sl = __builtin_amdgcn_readlane(offs, __builtin_amdgcn_readfirstlane(tope[(size_t)row * 4 + k])) + __builtin_amdgcn_readfirstlane(posb[(size_t)row * 4 + k]); const float gk = gate[(size_t)row * 4 + k];
#pragma unroll
            for (int j = 0; j < 4; ++j) { const unsigned w = *((const unsigned*)(YB + (size_t)sl * D) + F.lane + 64 * j);
                const f32x2 lo = __builtin_amdgcn_cvt_pk_f32_fp8(w, false) * gk + (f32x2){f[j][0], f[j][1]}, hi = __builtin_amdgcn_cvt_pk_f32_fp8(w, true) * gk + (f32x2){f[j][2], f[j][3]};
                f[j] = (f32x4){lo.x, lo.y, hi.x, hi.y}; } }
        f32x4 v[4], g2[4]; ld_row_bf16(v, X1 + (size_t)row * D, F.lane); ld_row(g2, mv + 5 * D, F.lane);
#pragma unroll
        for (int j = 0; j < 4; ++j) v[j] = DN_ALPHA * v[j] + g2[j] * f[j];
        layernorm_row(v, lng, lnb, F.lane);
        if (L == 0) {
            st_row_bf16(WSP(bf16_t, WS_XR) + (size_t)row * D, v, F.lane);
            const float* mv1 = WSP(float, WS_MODV) + (size_t)(5 + row_bi(row)) * NMOD;
            f32x4 sh[4], sc[4]; ld_row(sh, mv1, F.lane); ld_row(sc, mv1 + D, F.lane);
#pragma unroll
            for (int j = 0; j < 4; ++j) v[j] = v[j] * (1.0f + sc[j]) + sh[j];
            st_row_bf16(WSP(bf16_t, WS_H) + (size_t)row * D, v, F.lane);
        } else {
            st_row((float*)A.in(23) + (size_t)(row - NCTX) * D, v, F.lane);
        }
    }
}

constexpr int NPHASE = 19;
__global__ void __launch_bounds__(512, 2) mk_fwd(Args args) {
    extern __shared__ __attribute__((aligned(16))) unsigned char lds_raw[];
    Frame F;
    KArgs KA; KA.p = (const __attribute__((address_space(4))) unsigned char*)__builtin_amdgcn_kernarg_segment_ptr();
    F.lds = (ldsp_t)lds_raw;
    F.tid = threadIdx.x; F.lane = F.tid & 63; F.wave = __builtin_amdgcn_readfirstlane(F.tid >> 6);
    F.G = gridDim.x; { const int bx = blockIdx.x; F.vcu = (F.G % 8 == 0) ? (bx % 8) * (F.G / 8) + bx / 8 : bx; }
    F.ws = args.ws;
    for (int u = F.tid; u < (LDS_BYTES - LDSCTL_OFF) / 4; u += 512) ((LAS unsigned*)(F.lds + LDSCTL_OFF))[u] = 0u;
    __syncthreads();
    if (MK_MODE == 1) (void)xcd_barrier_post((unsigned*)(F.ws + WS_CTL) + CW_BAR, (volatile LAS unsigned*)(F.lds + MISC_OFF) + 8);
    const int lo = args.ph_lo, hi = args.ph_hi;
#ifndef PH_MASK
#define PH_MASK 0x7FFFF
#endif
#define IN(k) ((((PH_MASK) >> (k)) & 1) && lo <= (k) && (k) < hi)
#ifndef PROBE_SEAM
#define PROBE_SEAM 0
#endif
#define SEAM(k) do { if (IN(k) && IN((k) + 1)) { const XcdBarrier b_ = frame_barrier(F); xcd_barrier(b_); if (PROBE_SEAM) xcd_barrier(b_); } } while (0)
#define ARRIVE(k) do { if (IN(k) && IN((k) + 1)) { const XcdBarrier b_ = frame_barrier(F); xcd_arrive(b_); } } while (0)
#define WAIT(k) do { if (IN(k) && IN((k) + 1)) { const XcdBarrier b_ = frame_barrier(F); xcd_wait(b_); if (PROBE_SEAM) xcd_barrier(b_); } } while (0)
#ifndef PH_REPEAT
#define PH_REPEAT 0
#endif
#define REPBIT(k) (((PH_REPEAT) >> (k)) & 1)
#define FRESH_IDS() do { int l_ = lane_id(); asm volatile("" : "+v"(l_)); F.lane = l_; F.tid = F.wave * 64 + l_; } while (0)
#define PHASE(k, ...) do { if (IN(k)) { FRESH_IDS(); { __VA_ARGS__ } if (REPBIT(k)) { __VA_ARGS__ } } } while (0)

    PHASE(0,  p0_prologue(F, KA); ); SEAM(0);
    PHASE(1,  p_modulate0(F, KA); ); SEAM(1);
    PHASE(2,
        { pg8::Gemm g{D / 64, 2048u, 2048u}; GridOrder S; S.init(68, 5, F.G, F.vcu, 0, WSP(char, WS_H), 256u * 2048u, WSP(char, WS_WABI), 256u * 2048u);
          EpiIn0 E{WSP(bf16_t, WS_PB), WSP(float, WS_ROPE), WSP(float, WS_ROPE) + 1024};
          pg8::gemm_phase<EpiIn0, GridOrder, PG8_ALIGN, PG8_SP2>(F.lds, g, S, E, F.wave); }
        { pg8::Gemm g{D / 64, 2048u, 2048u}; GridOrder S; S.init(2, 68, F.G, F.vcu, 84, WSP(char, WS_WF), 256u * 2048u, WSP(char, WS_H), 256u * 2048u);
          EpiGT E{WSP(bf16_t, WS_GT), WSP(bf16_t, WS_GTC)};
          pg8::gemm_phase<EpiGT, GridOrder, PG8_ALIGN, PG8_SP2>(F.lds, g, S, E, F.wave); }
        if (F.G == 256 && F.vcu >= 220) bg_range(F, KA, BG_P2, 220, 3);
    ); SEAM(2);
    PHASE(3,  p_fourier1(F); ); ARRIVE(3);
    PHASE(4,
        p_attn0(F, KA);
        WAIT(3);
        { pg8::Gemm g{512 / 64, 1024u, 1024u}; FourierOrder S{F.G, (F.vcu + F.G - 48) % F.G, WSP(char, WS_ADFT), WSP(char, WS_YF), WSP(char, WS_GTC)};
          EpiFour E{WSP(bf16_t, WS_O)};
          pg8::gemm_phase<EpiFour, FourierOrder, PG8_ALIGN, PG8_SP2>(F.lds, g, S, E, F.wave); }
    ); SEAM(4);
    PHASE(5,
        pg8::Gemm g{D / 64, 2048u, 2048u}; GridOrder S; S.init(68, 4, F.G, F.vcu, 0, WSP(char, WS_O), 256u * 2048u, WSP(char, WS_WABO), 256u * 2048u);
        EpiY E{WSP(bf16_t, WS_Y), D};
        pg8::gemm_phase<EpiY, GridOrder, PG8_ALIGN, PG8_SP2>(F.lds, g, S, E, F.wave);
        if (F.G == 256 && F.vcu >= 16) bg_range(F, KA, BG_P5, 16, 2);
    ); ARRIVE(5);
#ifndef PROBE_ROWS1
#define PROBE_ROWS1 0
#endif
    PHASE(6,  p_rows1<0>(F, KA, 0, IN(5) && IN(6)); if (PROBE_ROWS1 == 1) p_rows1<0>(F, KA, 32); ); SEAM(6);
    PHASE(8,
        LAS int* tile_e = (LAS int*)(F.lds + LTAB_OFF); build_tile_table(F, 0, tile_e);
        pg8::Gemm g{D / 128, 1024u, 1024u};
        const MoeOrder S = moe_order(F, tile_e, 8, WSP(char, WS_XGE), 256u * 1024u, WSP(char, WS_WGU) + (size_t)0 * 32 * 2048 * D, 256u * 1024u, (size_t)2048 * D, CAPR / 256);
        EpiSwiglu E{WSP(unsigned char, WS_ACT), KA.in(20) + (size_t)0 * 32 * 2048};
        pg8::gemm_phase<EpiSwiglu, MoeOrder, PG8_ALIGN, PG8_SP2, true>(F.lds, g, S, E, F.wave);
        if (F.G == 256) { const int r9 = bg_moe_idle(S.T1, 4, 256), r8 = bg_moe_idle(S.T1, 8, 256); if (r8 != 0 && F.vcu >= r8) bg_range(F, KA, BG_P9 + (r9 ? (256 - r9) * 16 : 0), r8, 1); }
    ); SEAM(8);
    PHASE(9,
        LAS int* tile_e = (LAS int*)(F.lds + LTAB_OFF); if (!IN(8)) build_tile_table(F, 0, tile_e);
        pg8::Gemm g{FF / 128, 128u, 1024u, 256u * 128u, 128u};
        const MoeOrder S = moe_order(F, tile_e, 4, WSP(char, WS_ACT), 256u * 1024u, WSP(char, WS_WD) + (size_t)0 * 32 * D * FF, 256u * 1024u, (size_t)D * FF);
        EpiDown E{WSP(unsigned char, WS_XG), KA.in(22) + (size_t)0 * 32 * D};
        pg8::gemm_phase<EpiDown, MoeOrder, PG8_ALIGN, PG8_SP2, true>(F.lds, g, S, E, F.wave);
        if (F.G == 256) { const int r9 = bg_moe_idle(S.T1, 4, 256); if (r9 != 0 && F.vcu >= r9) bg_range(F, KA, BG_P9, r9, 2); }
    ); SEAM(9);
    PHASE(10,  p_rows2<0>(F, KA); ); SEAM(10);
    PHASE(11,
        pg8::Gemm g{D / 64, 2048u, 2048u}; GridOrder S; S.init(68, 9, F.G, F.vcu, 0, WSP(char, WS_H), 256u * 2048u, WSP(char, WS_WCDI), 256u * 2048u);
        EpiIn1 E{WSP(bf16_t, WS_PB), WSP(float, WS_ROPE), WSP(float, WS_ROPE) + 1024, KA.in(14), KA.in(15)};
        pg8::gemm_phase<EpiIn1, GridOrder, PG8_ALIGN, PG8_SP2>(F.lds, g, S, E, F.wave);
        if (F.G == 256 && F.vcu >= 100) bg_range(F, KA, BG_P11, 100, 3);
    ); SEAM(11);
    PHASE(12,  p_attn1(F, KA); ); SEAM(12);
    PHASE(13,
        pg8::Gemm g{D / 64, 2048u, 2048u}; GridOrder S; S.init(64, 4, F.G, F.vcu, 0, WSP(char, WS_O) + (size_t)NCTX * 2048u, 256u * 2048u, WSP(char, WS_WCDO), 256u * 2048u);
        EpiY E{WSP(bf16_t, WS_Y) + (size_t)NCTX * D, D};
        pg8::gemm_phase<EpiY, GridOrder, PG8_ALIGN, PG8_SP2>(F.lds, g, S, E, F.wave);
    ); ARRIVE(13);
    PHASE(14,  p_rows1<1>(F, KA, 0, IN(13) && IN(14)); if (PROBE_ROWS1 == 2) p_rows1<1>(F, KA, 32); __syncthreads();
        { int cnt_, total_; (void)expert_offsets(F, 0, cnt_, total_); const int T1 = __builtin_amdgcn_readfirstlane(total_) >> 8;
          int start = 0;
          if (F.G == 256) { const int r9 = bg_moe_idle(T1, 4, 256), r8 = bg_moe_idle(T1, 8, 256); start = BG_P9 + (r9 ? (256 - r9) * 16 : 0) + (r8 ? (256 - r8) * 8 : 0); }
          for (int s = start + F.vcu * 8 + F.wave; s < BG_TOTAL; s += F.G * 8) bg_step(F, KA, s); }
    ); SEAM(14);
    PHASE(16,
        LAS int* tile_e = (LAS int*)(F.lds + LTAB_OFF); build_tile_table(F, 1, tile_e);
        pg8::Gemm g{D / 128, 1024u, 1024u};
        const MoeOrder S = moe_order(F, tile_e, 8, WSP(char, WS_XGE), 256u * 1024u, WSP(char, WS_WGU) + (size_t)1 * 32 * 2048 * D, 256u * 1024u, (size_t)2048 * D, CAPR / 256);
        EpiSwiglu E{WSP(unsigned char, WS_ACT), KA.in(20) + (size_t)1 * 32 * 2048};
        pg8::gemm_phase<EpiSwiglu, MoeOrder, PG8_ALIGN, PG8_SP2, true>(F.lds, g, S, E, F.wave);
    ); SEAM(16);
    PHASE(17,
        LAS int* tile_e = (LAS int*)(F.lds + LTAB_OFF); if (!IN(16)) build_tile_table(F, 1, tile_e);
        pg8::Gemm g{FF / 128, 128u, 1024u, 256u * 128u, 128u};
        const MoeOrder S = moe_order(F, tile_e, 4, WSP(char, WS_ACT), 256u * 1024u, WSP(char, WS_WD) + (size_t)1 * 32 * D * FF, 256u * 1024u, (size_t)D * FF);
        EpiDown E{WSP(unsigned char, WS_XG), KA.in(22) + (size_t)1 * 32 * D};
        pg8::gemm_phase<EpiDown, MoeOrder, PG8_ALIGN, PG8_SP2, true>(F.lds, g, S, E, F.wave);
    ); SEAM(17);
    PHASE(18,  p_rows2<1>(F, KA); );
#undef IN
#undef SEAM
}

extern "C" void kernel_launch(void* const* d_in, const int* in_sizes, int n_in, void* d_out, int out_size, void* d_ws, size_t ws_size, hipStream_t stream) {
    static int grid = 0;
    if (grid == 0) {
        if (n_in != 23 || out_size != NLAT * D || ws_size < WS_END) { fprintf(stderr, "kernel_launch: unexpected shapes (n_in %d, out %d, ws %zu)\n", n_in, out_size, ws_size); grid = -1; return; }
        int dev = 0, cus = 0, per_cu = 0;
        if (hipGetDevice(&dev) != hipSuccess || hipDeviceGetAttribute(&cus, hipDeviceAttributeMultiprocessorCount, dev) != hipSuccess) { grid = -1; return; }
        if (hipFuncSetAttribute((const void*)mk_fwd, hipFuncAttributeMaxDynamicSharedMemorySize, LDS_BYTES) != hipSuccess) { fprintf(stderr, "kernel_launch: hipFuncSetAttribute failed\n"); grid = -1; return; }
        if (hipOccupancyMaxActiveBlocksPerMultiprocessor(&per_cu, (const void*)mk_fwd, 512, LDS_BYTES) != hipSuccess || per_cu < 1) { fprintf(stderr, "kernel_launch: occupancy query reports %d\n", per_cu); }
        (void)hipGetLastError();
        grid = cus;
    }
    if (grid < 0) return;
    if (hipMemsetAsync((char*)d_ws + WS_CTL, 0, CTL_ZERO_BYTES, stream) != hipSuccess) return;
    Args a{};
    for (int i = 0; i < 23; ++i) a.in[i] = (const float*)d_in[i];
    a.out = (float*)d_out; a.ws = (unsigned char*)d_ws;
#if MK_MODE == 1
    a.ph_lo = 0; a.ph_hi = NPHASE;
    hipLaunchKernelGGL(mk_fwd, dim3(grid), dim3(512), LDS_BYTES, stream, a);
#else
#ifndef PROBE_PHASE
#define PROBE_PHASE -1
#endif
    for (int p = 0; p < NPHASE; ++p) { a.ph_lo = p; a.ph_hi = p + 1; for (int r = 0; r < (p == PROBE_PHASE ? 2 : 1); ++r) hipLaunchKernelGGL(mk_fwd, dim3(grid), dim3(512), LDS_BYTES, stream, a); }
#endif
}
```

```cpp
#include <hip/hip_runtime.h>
#include <cstdio>
#include <cstdint>

#ifndef MK_MODE
#define MK_MODE 1
#endif

#define LAS __attribute__((address_space(3)))
#define GAS __attribute__((address_space(1)))
typedef unsigned short bf16_t;
typedef short bf16x8 __attribute__((ext_vector_type(8)));
typedef short s16x4 __attribute__((ext_vector_type(4)));
typedef float f32x2 __attribute__((ext_vector_type(2)));
typedef float f32x4 __attribute__((ext_vector_type(4)));
typedef float f32x16 __attribute__((ext_vector_type(16)));
typedef unsigned u32x2 __attribute__((ext_vector_type(2)));
typedef unsigned u32x4 __attribute__((ext_vector_type(4)));
typedef LAS unsigned char* ldsp_t;

constexpr int D = 1024, BATCH = 4, SEQ = 4096, CTXL = 256;
constexpr int NCTX = BATCH * CTXL;
constexpr int NLAT = BATCH * SEQ;
constexpr int NROW = NCTX + NLAT;
constexpr int NE = 32, TOPK = 4, FF = 1024;
constexpr int NMOD = 6 * D;
constexpr int AB_N = 1280;
constexpr int CD_N = 2304;
constexpr float LN_EPS = 1e-6f, RMS_EPS = 1e-6f;
constexpr float DN_ALPHA = 1.41421356237f;
constexpr float LAMBDA_INIT1 = 0.35550907f;
constexpr float QSCALE = 0.125f * 1.4426950408889634f;
constexpr float LOG2E = 1.4426950408889634f;
constexpr float WGU_SCALE = 32.0f, WD_SCALE = 64.0f;
constexpr int RP_MAX = 77824;

constexpr size_t MiB = 1u << 20;
constexpr size_t WS_CTL = 0, CTL_ZERO_BYTES = 1 * MiB;
constexpr size_t WS_MODV = 1 * MiB;
constexpr size_t WS_ROPE = 1 * MiB + 512 * 1024;
constexpr size_t WS_TOPE = 2 * MiB, WS_GATE = 2 * MiB + 512 * 1024, WS_POS = 3 * MiB, WS_SLOT = 3 * MiB + 512 * 1024;
constexpr size_t WS_ADFT = 4 * MiB;
constexpr size_t WS_WF = 9 * MiB;
constexpr size_t WS_WABI = 10 * MiB;
constexpr size_t WS_WABO = 13 * MiB;
constexpr size_t WS_WCDI = 15 * MiB;
constexpr size_t WS_WCDO = 20 * MiB;
constexpr size_t WS_WGU = 32 * MiB;
constexpr size_t WS_WD = 288 * MiB;
constexpr size_t WS_X1 = 416 * MiB;
constexpr size_t WS_XR = 484 * MiB;
constexpr size_t WS_H = 552 * MiB;
constexpr size_t WS_PB = 586 * MiB;
constexpr size_t WS_GT = 664 * MiB;
constexpr size_t WS_GTC = 680 * MiB;
constexpr size_t WS_YF = 681 * MiB;
constexpr size_t WS_O = 697 * MiB;
constexpr size_t WS_Y = 731 * MiB;
constexpr size_t WS_XG = 800 * MiB;
constexpr size_t WS_ACT = 952 * MiB;
constexpr size_t WS_XGE = 1104 * MiB;
constexpr int CAPR = NROW;
constexpr size_t WS_END = (1104 + 544) * MiB;
constexpr int CW_BAR = 4096;
constexpr int CW_CNT = 8192;

constexpr int RING_BYTES = 131072;
constexpr int LDSCTL_OFF = RING_BYTES;
constexpr int MISC_OFF = LDSCTL_OFF + 320;
constexpr int LTAB_OFF = LDSCTL_OFF + 1024;
constexpr int LDS_BYTES = 147456;

#define RLX_AGENT __ATOMIC_RELAXED, __HIP_MEMORY_SCOPE_AGENT
#define LDS_WAIT() asm volatile("s_waitcnt lgkmcnt(0)" ::: "memory")
#define VM_WAIT() asm volatile("s_waitcnt vmcnt(0)" ::: "memory")
__device__ __forceinline__ unsigned f2bf(float f) { unsigned u = __builtin_bit_cast(unsigned, f); return (u + 0x7fffu + ((u >> 16) & 1u)) >> 16; }
__device__ __forceinline__ unsigned pk2(float lo, float hi) { return f2bf(lo) | (f2bf(hi) << 16); }
__device__ __forceinline__ unsigned cvt_pk_bf16(float lo, float hi) { unsigned r; asm volatile("v_cvt_pk_bf16_f32 %0, %1, %2" : "=v"(r) : "v"(lo), "v"(hi)); return r; }
__device__ __forceinline__ unsigned pk4_fp8(float a, float b, float c, float d) { int w = 0; w = __builtin_amdgcn_cvt_pk_fp8_f32(a, b, w, false); w = __builtin_amdgcn_cvt_pk_fp8_f32(c, d, w, true); return (unsigned)w; }
__device__ __forceinline__ float bf2f(unsigned h) { return __builtin_bit_cast(float, h << 16); }
__device__ __forceinline__ int lane_id() { return (int)__builtin_amdgcn_mbcnt_hi(~0u, __builtin_amdgcn_mbcnt_lo(~0u, 0u)); }
constexpr int DPP_XOR1 = 0xB1, DPP_XOR2 = 0x4E, DPP_XOR3 = 0x1B, DPP_XOR7 = 0x141, DPP_XOR15 = 0x140, DPP_XOR8 = 0x128;
template <int CTRL> __device__ __forceinline__ float dppf(float x) { return __builtin_bit_cast(float, __builtin_amdgcn_update_dpp(0, __builtin_bit_cast(int, x), CTRL, 0xF, 0xF, true)); }
template <int CTRL> __device__ __forceinline__ int dppi(int x) { return __builtin_amdgcn_update_dpp(0, x, CTRL, 0xF, 0xF, true); }
__device__ __forceinline__ void swap16(float& a, float& b) { auto r = __builtin_amdgcn_permlane16_swap(__builtin_bit_cast(unsigned, a), __builtin_bit_cast(unsigned, b), false, false); const unsigned r0 = r[0], r1 = r[1]; a = __builtin_bit_cast(float, r0); b = __builtin_bit_cast(float, r1); }
__device__ __forceinline__ void swap32(float& a, float& b) { auto r = __builtin_amdgcn_permlane32_swap(__builtin_bit_cast(unsigned, a), __builtin_bit_cast(unsigned, b), false, false); const unsigned r0 = r[0], r1 = r[1]; a = __builtin_bit_cast(float, r0); b = __builtin_bit_cast(float, r1); }
__device__ __forceinline__ float wave_sum(float v) {
    v += dppf<DPP_XOR1>(v); v += dppf<DPP_XOR2>(v); v += dppf<DPP_XOR7>(v); v += dppf<DPP_XOR15>(v);
    { float a = v, b = v; swap16(a, b); v = a + b; }
    { float a = v, b = v; swap32(a, b); v = a + b; }
    return v;
}

#define XB_TMO      128
#define XB_XCNT(j)  (256  + 64 * (j))
#define XB_XSUB(j)  (1280 + 64 * (j))
#define XB_XGEN(j)  (2304 + 64 * (j))
#define XB_TOP      3328
#define XB_TOPGEN   3392
#define XCD_BAR_WORDS 3456
#define XB_SPIN_CAP (1u << 18)
__device__ __forceinline__ unsigned xb_ld(unsigned* p)              { return __hip_atomic_load(p, __ATOMIC_RELAXED, __HIP_MEMORY_SCOPE_AGENT); }
__device__ __forceinline__ unsigned xb_add(unsigned* p, unsigned v) { return __hip_atomic_fetch_add(p, v, __ATOMIC_RELAXED, __HIP_MEMORY_SCOPE_AGENT); }
__device__ __forceinline__ unsigned xb_xcc_id() { return (unsigned)__builtin_amdgcn_s_getreg((3 << 11) | 20) & 0xFu; }
#define XB_SPIN(cond, bar) do { unsigned _sp = 0; while (cond) { __builtin_amdgcn_s_sleep(1); \
    if ((++_sp & 255u) == 0u) { if (xb_ld(&(bar)[XB_TMO])) break; if (_sp > XB_SPIN_CAP) { atomicAdd(&(bar)[XB_TMO], 1u); break; } } } } while (0)
struct XcdBarrier { unsigned* bar; unsigned x; volatile LAS unsigned* st; };
__device__ __forceinline__ XcdBarrier xcd_barrier_post(unsigned* bar, volatile LAS unsigned* st) {
    XcdBarrier b; b.bar = bar; b.x = xb_xcc_id(); b.st = st;
    if (threadIdx.x == 0) (void)xb_add(&bar[XB_XCNT(b.x)], 1u);
    return b;
}
__device__ __forceinline__ void xcd_barrier_complete(unsigned* bar, unsigned x, unsigned& nloc, unsigned& nx) {
    const unsigned G = gridDim.x * gridDim.y * gridDim.z;
    unsigned sum, cnt, mine, sp = 0u;
    for (;;) {
        sum = 0u; cnt = 0u; mine = 0u;
#pragma unroll
        for (unsigned j = 0; j < 16; ++j) { const unsigned c = xb_ld(&bar[XB_XCNT(j)]); sum += c; cnt += (c > 0u) ? 1u : 0u; mine = (j == x) ? c : mine; }
        if (sum == G) break;
        __builtin_amdgcn_s_sleep(1);
        if ((++sp & 255u) == 0u) { if (xb_ld(&bar[XB_TMO])) break; if (sp > XB_SPIN_CAP) { atomicAdd(&bar[XB_TMO], 1u); break; } }
    }
    nloc = mine > 0u ? mine : 1u; nx = cnt > 0u ? cnt : 1u;
}
__device__ __forceinline__ void xcd_arrive(const XcdBarrier& b) {
    asm volatile("s_waitcnt vmcnt(0)" ::: "memory");
    __syncthreads();
    if (threadIdx.x == 0) {
        unsigned* bar = b.bar;
        __builtin_amdgcn_s_waitcnt(0);
        unsigned nloc = b.st[0], nx = b.st[1];
        if (nloc == 0u) { xcd_barrier_complete(bar, b.x, nloc, nx); b.st[0] = nloc; b.st[1] = nx; }
        const unsigned old = xb_add(&bar[XB_XSUB(b.x)], 1u);
        const unsigned gen = old / nloc;
        if (old + 1u == (gen + 1u) * nloc) {
            __builtin_amdgcn_fence(__ATOMIC_RELEASE, "agent");
            asm volatile("s_waitcnt vmcnt(0)" ::: "memory");
            (void)xb_add(&bar[XB_TOP], 1u);
        }
        b.st[2] = (gen + 1u) * nx;
    }
}
__device__ __forceinline__ void xcd_wait(const XcdBarrier& b) {
    if (threadIdx.x == 0) {
        unsigned* bar = b.bar;
        const unsigned target = b.st[2];
        XB_SPIN(xb_ld(&bar[XB_TOP]) < target, bar);
        __builtin_amdgcn_fence(__ATOMIC_ACQUIRE, "agent");
        asm volatile("s_waitcnt vmcnt(0)" ::: "memory");
    }
    __syncthreads();
}
__device__ __forceinline__ void xcd_barrier(const XcdBarrier& b) { xcd_arrive(b); xcd_wait(b); }

namespace pg8 {
constexpr int BM = 256, BK = 64, HALF = 128, HTB = HALF * BK * 2, STAGE_BYTES = 8 * HTB;
__host__ __device__ __forceinline__ int lds_byte(int r, int c) { const int st = (r >> 4) * 2 + (c >> 5), rr = r & 15, cc = c & 31, ob = rr * 64 + cc * 2; return st * 1024 + (ob ^ (((ob >> 9) & 1) << 5)); }
__host__ __device__ __forceinline__ void stage_rc(int b, int& R, int& C) { const int st = b / 1024, sb = b % 1024, swz = sb ^ (((sb >> 9) & 1) << 5); R = (st >> 1) * 16 + swz / 64; C = (st & 1) * 32 + (swz % 64) / 2; }
__host__ __device__ __forceinline__ int perm32(int rho) { const int n = rho >> 4, i = rho & 15; return 8 * (i >> 2) + 4 * n + (i & 3); }

struct Unit { int pm, pn, aux, rot; const char* a; const char* b; };
struct Gemm { int nkt; unsigned lda, ldb, ksA = 128u, ksB = 128u; };

typedef int i32x8 __attribute__((ext_vector_type(8)));
typedef int i32x4 __attribute__((ext_vector_type(4)));
__device__ __forceinline__ i32x8 cat8(bf16x8 lo, bf16x8 hi) { return __builtin_shufflevector(__builtin_bit_cast(i32x4, lo), __builtin_bit_cast(i32x4, hi), 0, 1, 2, 3, 4, 5, 6, 7); }
template <class Epi, class Sched, bool ALIGN_EPI = false, bool SP2 = false, bool FP8 = false>
__device__ __forceinline__ void gemm_phase(ldsp_t lds, const Gemm g, const Sched& S, const Epi& E, const int wid) {
    const int lane = lane_id(), tid = wid * 64 + lane; const int wr = wid >> 2, wc = wid & 3, fr = lane & 15, fq = lane >> 4;
    int nt = g.nkt; asm volatile("" : "+s"(nt));
    unsigned voffA, voffB;
    { int R, C; stage_rc(tid * 16, R, C); const int Rb = Epi::PERM ? ((R & ~31) + perm32(R & 31)) : R;
      voffA = (unsigned)R * g.lda + (unsigned)C * 2u; voffB = (unsigned)Rb * g.ldb + (unsigned)C * 2u; }
    const size_t p1A = (size_t)64 * g.lda, p1B = (size_t)64 * g.ldb;
    const size_t kstepA = g.ksA, kstepB = g.ksB;
    const size_t hstepA = (size_t)HALF * g.lda, hstepB = (size_t)HALF * g.ldb;
    const unsigned ldsw = (unsigned)wid * 1024u;
    const int aoff = lds_byte(wr * 64 + fr, fq * 8), boff = lds_byte(wc * 32 + fr, fq * 8);
    constexpr int KFS = 1024;
#define PG8_SA(b, h) (((b) * 2 + (h)) * HTB)
#define PG8_SB(b, h) ((4 + (b) * 2 + (h)) * HTB)
#define PG8_STAGE(bufoff, gbase, voff) do { \
        __builtin_amdgcn_global_load_lds((const unsigned*)((const char*)(gbase) + (voff)), (LAS unsigned*)(lds + (bufoff) + ldsw), 16, 0, 0); \
        __builtin_amdgcn_global_load_lds((const unsigned*)((const char*)(gbase) + ((&(voff) == &voffA) ? p1A : p1B) + (voff)), (LAS unsigned*)(lds + (bufoff) + ldsw + 8192), 16, 0, 0); } while (0)
#define PG8_LDA(dst, b, h) do { _Pragma("unroll") for (int m = 0; m < 4; ++m) _Pragma("unroll") for (int k = 0; k < 2; ++k) dst[m][k] = *(const LAS bf16x8*)(lds + PG8_SA(b, h) + aoff + m * 2048 + k * KFS); } while (0)
#define PG8_LDB(dst, b, h) do { _Pragma("unroll") for (int n = 0; n < 2; ++n) _Pragma("unroll") for (int k = 0; k < 2; ++k) dst[n][k] = *(const LAS bf16x8*)(lds + PG8_SB(b, h) + boff + n * 2048 + k * KFS); } while (0)
#define PG8_MMA(ai, bj, At, Bt) do { __builtin_amdgcn_s_setprio(1); _Pragma("unroll") for (int m = 0; m < 4; ++m) _Pragma("unroll") for (int n = 0; n < 2; ++n) { \
        if constexpr (FP8) acc[ai][bj][m][n] = __builtin_amdgcn_mfma_scale_f32_16x16x128_f8f6f4(cat8(Bt[n][0], Bt[n][1]), cat8(At[m][0], At[m][1]), acc[ai][bj][m][n], 0, 0, 0, 0, 0, 0); \
        else { _Pragma("unroll") for (int k = 0; k < 2; ++k) acc[ai][bj][m][n] = __builtin_amdgcn_mfma_f32_16x16x32_bf16(Bt[n][k], At[m][k], acc[ai][bj][m][n], 0, 0, 0); } } \
        __builtin_amdgcn_s_setprio(0); } while (0)
#define PG8_WAIT_V(n) asm volatile("s_waitcnt vmcnt(" #n ")" ::: "memory")
#define PG8_WAIT_L(n) asm volatile("s_waitcnt lgkmcnt(" #n ")" ::: "memory")
#define PG8_BAR __builtin_amdgcn_s_barrier()
#define PG8_SCHED __builtin_amdgcn_sched_barrier(0)
    Unit cur, nxt; int ui = 0;
    if (!S.next(0, cur)) return;
    f32x4 acc[2][2][4][2];
#pragma unroll
    for (int a = 0; a < 2; ++a)
#pragma unroll
        for (int b = 0; b < 2; ++b)
#pragma unroll
            for (int m = 0; m < 4; ++m)
#pragma unroll
                for (int n = 0; n < 2; ++n) acc[a][b][m][n] = (f32x4){0.f, 0.f, 0.f, 0.f};
    bf16x8 At[4][2], B0[2][2], B1[2][2];
    const int km = nt - 1;
#define PG8_KA(t, rot) ((size_t)((((t) + (rot)) & km)) * kstepA)
#define PG8_KB(t, rot) ((size_t)((((t) + (rot)) & km)) * kstepB)
    const char* cA = cur.a; const char* cB = cur.b; int cr = cur.rot & km;
    if constexpr (SP2) {
        PG8_STAGE(PG8_SB(0, 0), cB + PG8_KB(0, cr), voffB); PG8_STAGE(PG8_SB(0, 1), cB + hstepB + PG8_KB(0, cr), voffB); PG8_STAGE(PG8_SA(0, 0), cA + PG8_KA(0, cr), voffA); PG8_STAGE(PG8_SA(0, 1), cA + hstepA + PG8_KA(0, cr), voffA);
        if (wr == 1) PG8_BAR;
        PG8_WAIT_V(2); PG8_BAR;
        PG8_STAGE(PG8_SB(1, 0), cB + PG8_KB(1, cr), voffB); PG8_STAGE(PG8_SA(1, 0), cA + PG8_KA(1, cr), voffA); PG8_STAGE(PG8_SB(1, 1), cB + hstepB + PG8_KB(1, cr), voffB);
        PG8_WAIT_V(6); PG8_BAR;
    } else {
        PG8_STAGE(PG8_SB(0, 0), cB + PG8_KB(0, cr), voffB); PG8_STAGE(PG8_SA(0, 0), cA + PG8_KA(0, cr), voffA); PG8_STAGE(PG8_SB(0, 1), cB + hstepB + PG8_KB(0, cr), voffB); PG8_STAGE(PG8_SA(0, 1), cA + hstepA + PG8_KA(0, cr), voffA);
        if (wr == 1) PG8_BAR;
        PG8_WAIT_V(4); PG8_BAR;
        PG8_STAGE(PG8_SB(1, 0), cB + PG8_KB(1, cr), voffB); PG8_STAGE(PG8_SA(1, 0), cA + PG8_KA(1, cr), voffA); PG8_STAGE(PG8_SB(1, 1), cB + hstepB + PG8_KB(1, cr), voffB);
        PG8_WAIT_V(6); PG8_BAR;
    }
    for (;;) {
        const bool has_next = S.next(ui + 1, nxt);
        const char* nA = has_next ? nxt.a : cA; const char* nB = has_next ? nxt.b : cB; const int nr = has_next ? (nxt.rot & km) : cr;
        for (int t = 0; t < nt; t += 2) {
            const bool last = (t == nt - 2);
            const char* a1 = cA + PG8_KA(t + 1, cr);
            const char* a2 = last ? nA + PG8_KA(0, nr) : cA + PG8_KA(t + 2, cr); const char* b2 = last ? nB + PG8_KB(0, nr) : cB + PG8_KB(t + 2, cr);
            const char* a3 = last ? nA + PG8_KA(1, nr) : cA + PG8_KA(t + 3, cr); const char* b3 = last ? nB + PG8_KB(1, nr) : cB + PG8_KB(t + 3, cr);
            if constexpr (SP2) {
            PG8_LDB(B0, 0, 0); PG8_LDB(B1, 0, 1); PG8_SCHED; PG8_LDA(At, 0, 0); PG8_STAGE(PG8_SA(1, 1), a1 + hstepA, voffA);
            PG8_WAIT_V(8); PG8_WAIT_L(0); PG8_BAR; PG8_MMA(0, 0, At, B0); PG8_MMA(0, 1, At, B1); PG8_BAR; PG8_SCHED;
            PG8_LDA(At, 0, 1); PG8_STAGE(PG8_SB(0, 0), b2, voffB); PG8_STAGE(PG8_SB(0, 1), b2 + hstepB, voffB); PG8_STAGE(PG8_SA(0, 0), a2, voffA);
            PG8_WAIT_V(8); PG8_WAIT_L(0); PG8_BAR; PG8_MMA(1, 0, At, B0); PG8_MMA(1, 1, At, B1); PG8_BAR; PG8_SCHED;
            PG8_LDB(B0, 1, 0); PG8_LDB(B1, 1, 1); PG8_SCHED; PG8_LDA(At, 1, 0); PG8_STAGE(PG8_SA(0, 1), a2 + hstepA, voffA);
            PG8_WAIT_V(8); PG8_WAIT_L(0); PG8_BAR; PG8_MMA(0, 0, At, B0); PG8_MMA(0, 1, At, B1); PG8_BAR; PG8_SCHED;
            PG8_LDA(At, 1, 1); PG8_STAGE(PG8_SB(1, 0), b3, voffB); PG8_STAGE(PG8_SB(1, 1), b3 + hstepB, voffB); PG8_STAGE(PG8_SA(1, 0), a3, voffA);
            PG8_WAIT_V(8); PG8_WAIT_L(0); PG8_BAR; PG8_MMA(1, 0, At, B0); PG8_MMA(1, 1, At, B1); PG8_BAR; PG8_SCHED;
            } else {
            PG8_LDB(B0, 0, 0); PG8_SCHED; PG8_LDA(At, 0, 0); PG8_STAGE(PG8_SA(1, 1), a1 + hstepA, voffA);
            PG8_WAIT_L(8); PG8_BAR; PG8_WAIT_L(0); PG8_MMA(0, 0, At, B0); PG8_BAR; PG8_SCHED;
            PG8_LDB(B1, 0, 1); PG8_STAGE(PG8_SB(0, 0), b2, voffB);
            PG8_BAR; PG8_WAIT_L(0); PG8_MMA(0, 1, At, B1); PG8_BAR;
            PG8_LDA(At, 0, 1); PG8_STAGE(PG8_SA(0, 0), a2, voffA);
            PG8_BAR; PG8_WAIT_L(0); PG8_MMA(1, 0, At, B0); PG8_BAR; PG8_SCHED;
            PG8_STAGE(PG8_SB(0, 1), b2 + hstepB, voffB);
            PG8_WAIT_V(6); PG8_BAR; PG8_MMA(1, 1, At, B1); PG8_BAR;
            PG8_LDB(B0, 1, 0); PG8_SCHED; PG8_LDA(At, 1, 0); PG8_STAGE(PG8_SA(0, 1), a2 + hstepA, voffA);
            PG8_WAIT_L(8); PG8_BAR; PG8_WAIT_L(0); PG8_MMA(0, 0, At, B0); PG8_BAR; PG8_SCHED;
            PG8_LDB(B1, 1, 1); PG8_STAGE(PG8_SB(1, 0), b3, voffB);
            PG8_BAR; PG8_WAIT_L(0); PG8_MMA(0, 1, At, B1); PG8_BAR;
            PG8_LDA(At, 1, 1); PG8_STAGE(PG8_SA(1, 0), a3, voffA);
            PG8_BAR; PG8_WAIT_L(0); PG8_MMA(1, 0, At, B0); PG8_BAR; PG8_SCHED;
            PG8_STAGE(PG8_SB(1, 1), b3 + hstepB, voffB);
            PG8_WAIT_V(6); PG8_BAR; PG8_MMA(1, 1, At, B1); PG8_BAR;
            }
        }
        if constexpr (ALIGN_EPI) { if (wr == 0) PG8_BAR; }
#ifndef PROBE_EPI2
#define PROBE_EPI2 0
#endif
        { int lane_e = lane_id(); asm volatile("" : "+v"(lane_e)); E(acc, cur, wr, wc, lane_e & 15, lane_e >> 4); if (PROBE_EPI2 && FP8) { asm volatile("" : "+v"(lane_e)); E(acc, cur, wr, wc, lane_e & 15, lane_e >> 4); } }
        if (!has_next) break;
#pragma unroll
        for (int a = 0; a < 2; ++a)
#pragma unroll
            for (int b = 0; b < 2; ++b)
#pragma unroll
                for (int m = 0; m < 4; ++m)
#pragma unroll
                    for (int n = 0; n < 2; ++n) acc[a][b][m][n] = (f32x4){0.f, 0.f, 0.f, 0.f};
        cur = nxt; cA = nA; cB = nB; cr = nr; ++ui;
        if constexpr (ALIGN_EPI) { if (wr == 1) PG8_BAR; }
    }
    PG8_WAIT_V(0);
    if constexpr (!ALIGN_EPI) { if (wr == 0) PG8_BAR; }
    PG8_BAR;
#undef PG8_KA
#undef PG8_KB
#undef PG8_SA
#undef PG8_SB
#undef PG8_STAGE
#undef PG8_LDA
#undef PG8_LDB
#undef PG8_MMA
#undef PG8_WAIT_V
#undef PG8_WAIT_L
#undef PG8_BAR
#undef PG8_SCHED
}
}
#ifndef PG8_SP2
#define PG8_SP2 true
#endif
#ifndef PG8_ALIGN
#define PG8_ALIGN true
#endif

struct Args { const float* in[23]; float* out; unsigned char* ws; int ph_lo, ph_hi; };
typedef const float* cfptr_t;
struct KArgs { const __attribute__((address_space(4))) unsigned char* p;
    __device__ __forceinline__ const float* in(int k) const { return *(const __attribute__((address_space(4))) cfptr_t*)(p + 8 * k); } };
struct Frame {
    ldsp_t lds;
    int tid, lane, wave, vcu, G;
    unsigned char* ws;
};
#define WSP(T, off) ((T*)(F.ws + (off)))

struct GridOrder {
    int nM, nN, G, c; const char* A; const char* B; size_t a_tile, b_tile;
    __device__ __forceinline__ void init(int nM_, int nN_, int G_, int vcu, int shift, const void* A_, size_t a_tile_, const void* B_, size_t b_tile_) {
        nM = nM_; nN = nN_; G = G_; c = (vcu + G_ - (shift % G_)) % G_; A = (const char*)A_; B = (const char*)B_; a_tile = a_tile_; b_tile = b_tile_; }
    __device__ __forceinline__ bool next(int i, pg8::Unit& u) const {
        const int L = i * G + c; if (L >= nM * nN) return false;
        u.pm = L / nN; u.pn = L % nN; u.aux = 0; u.rot = 0; u.a = A + (size_t)u.pm * a_tile; u.b = B + (size_t)u.pn * b_tile; return true; }
};
struct MoeOrder {
    int nN, per, j, T0, T1, a_cap; const LAS int* tile_e; const char* A; const char* B; size_t a_tile, b_tile, b_exp;
    __device__ __forceinline__ bool next(int i, pg8::Unit& u) const {
        const int Ll = i * per + j; if (Ll >= (T1 - T0) * nN) return false;
        u.pm = T0 + Ll / nN; u.pn = Ll % nN; const int e = __builtin_amdgcn_readfirstlane(tile_e[u.pm]); u.aux = e; u.rot = u.pn + 2 * (u.pm & 3);
        const int at = a_cap ? e * a_cap + (u.pm - __builtin_amdgcn_readfirstlane(tile_e[320 + e])) : u.pm;
        u.a = A + (size_t)at * a_tile; u.b = B + (size_t)e * b_exp + (size_t)u.pn * b_tile; return true; }
};
struct FourierOrder {
    int G, c; const char* A; const char* YF; const char* GTC;
    __device__ __forceinline__ bool next(int i, pg8::Unit& u) const {
        const int L = i * G + c; if (L >= 68) return false;
        const int gi = L >> 2, b = L & 3; u.pm = gi; u.pn = b; u.aux = 0; u.rot = 0;
        u.a = A + (size_t)gi * (256u * 1024u);
        u.b = gi < 16 ? YF + ((size_t)gi * 1024u + (size_t)b * 256u) * 1024u : GTC + (size_t)b * (256u * 1024u);
        return true; }
};

__device__ __forceinline__ void st_bf16x4(bf16_t* p, f32x4 v) { u32x2 w; w.x = cvt_pk_bf16(v[0], v[1]); w.y = cvt_pk_bf16(v[2], v[3]); *(u32x2*)p = w; }
__device__ __forceinline__ void st_bf16x8(bf16_t* p, f32x4 v0, f32x4 v1) { u32x4 w; w.x = cvt_pk_bf16(v0[0], v0[1]); w.y = cvt_pk_bf16(v0[2], v0[3]); w.z = cvt_pk_bf16(v1[0], v1[1]); w.w = cvt_pk_bf16(v1[2], v1[3]); *(u32x4*)p = w; }

struct EpiIn0 {
    static constexpr bool PERM = true;
    bf16_t* P; const float* ropec; const float* ropes;
    __device__ __forceinline__ void operator()(const f32x4 (&acc)[2][2][4][2], const pg8::Unit& u, int wr, int wc, int fr, int fq) const {
        const int pn = u.pn; const int colbase = pn * 256 + wc * 64;
        const float qs = (pn <= 2) ? QSCALE : 1.0f;
#pragma unroll
        for (int ai = 0; ai < 2; ++ai)
#pragma unroll
            for (int m = 0; m < 4; ++m) {
                const int row = u.pm * 256 + ai * 128 + wr * 64 + m * 16 + fr;
                const bool rot = (row >= NCTX) && (pn <= 3);
                const int t = (row - NCTX) & (SEQ - 1);
                bf16_t* rp = P + (size_t)row * AB_N + colbase + 8 * fq;
#pragma unroll
                for (int bj = 0; bj < 2; ++bj) {
                    f32x4 x0 = acc[ai][bj][m][0], x1 = acc[ai][bj][m][1];
                    if (rot) { const int pos = bj ? (t & 63) : (t >> 6);
                        const f32x4 c = *(const f32x4*)(ropec + pos * 16 + 4 * fq), s = *(const f32x4*)(ropes + pos * 16 + 4 * fq);
                        const f32x4 y0 = x0 * c - x1 * s, y1 = x1 * c + x0 * s; x0 = y0; x1 = y1; }
                    x0 = x0 * qs; x1 = x1 * qs;
                    st_bf16x8(rp + 32 * bj, x0, x1);
                }
            }
    }
};
struct EpiIn1 {
    static constexpr bool PERM = true;
    bf16_t* P; const float* ropec; const float* ropes; const float* qg; const float* kg;
    __device__ __forceinline__ void operator()(const f32x4 (&acc)[2][2][4][2], const pg8::Unit& u, int wr, int wc, int fr, int fq) const {
        const int gidx = u.pn * 4 + wc;
        const bool isq = gidx < 16, norm = (gidx >= 8 && gidx < 16) || gidx == 24 || gidx == 25, ropeable = gidx < 26;
        const float* gv = (gidx < 16) ? qg : kg;
        const float qs = isq ? QSCALE : 1.0f;
        f32x4 g4[2][2];
#pragma unroll
        for (int bj = 0; bj < 2; ++bj)
#pragma unroll
            for (int n = 0; n < 2; ++n) g4[bj][n] = norm ? *(const f32x4*)(gv + 32 * bj + 16 * n + 4 * fq) : (f32x4){1.f, 1.f, 1.f, 1.f};
#pragma unroll
        for (int ai = 0; ai < 2; ++ai)
#pragma unroll
            for (int m = 0; m < 4; ++m) {
                const int row = u.pm * 256 + ai * 128 + wr * 64 + m * 16 + fr;
                const bool rot = (row >= NCTX) && ropeable;
                const int t = (row - NCTX) & (SEQ - 1);
                float rs = 1.0f;
                if (norm) { float ss = 0.f;
#pragma unroll
                    for (int bj = 0; bj < 2; ++bj)
#pragma unroll
                        for (int n = 0; n < 2; ++n) { const f32x4 x = acc[ai][bj][m][n]; ss += (x[0] * x[0] + x[1] * x[1]) + (x[2] * x[2] + x[3] * x[3]); }
                    { float sa = ss, sb = ss; swap16(sa, sb); ss = sa + sb; sa = ss; sb = ss; swap32(sa, sb); ss = sa + sb; }
                    rs = 1.0f / sqrtf(ss * (1.0f / 64.0f) + RMS_EPS); }
                bf16_t* rp = P + (size_t)row * CD_N + gidx * 64 + 8 * fq;
#pragma unroll
                for (int bj = 0; bj < 2; ++bj) {
                    f32x4 x0 = acc[ai][bj][m][0] * rs * g4[bj][0], x1 = acc[ai][bj][m][1] * rs * g4[bj][1];
                    if (rot) { const int pos = bj ? (t & 63) : (t >> 6);
                        const f32x4 c = *(const f32x4*)(ropec + pos * 16 + 4 * fq), s = *(const f32x4*)(ropes + pos * 16 + 4 * fq);
                        const f32x4 y0 = x0 * c - x1 * s, y1 = x1 * c + x0 * s; x0 = y0; x1 = y1; }
                    x0 = x0 * qs; x1 = x1 * qs;
                    st_bf16x8(rp + 32 * bj, x0, x1);
                }
            }
    }
};
struct EpiGT {
    static constexpr bool PERM = true;
    bf16_t* GT; bf16_t* GTC;
    __device__ __forceinline__ void operator()(const f32x4 (&acc)[2][2][4][2], const pg8::Unit& u, int wr, int wc, int fr, int fq) const {
        const int s = u.pm, tok0 = u.pn * 256;
        bf16_t* base; int T, b, t0;
        if (tok0 < NCTX) { b = tok0 >> 8; t0 = 0; T = CTXL; base = GTC; } else { b = (tok0 - NCTX) >> 12; t0 = (tok0 - NCTX) & (SEQ - 1); T = SEQ; base = GT; }
#pragma unroll
        for (int ai = 0; ai < 2; ++ai)
#pragma unroll
            for (int m = 0; m < 4; ++m) { const int cp = ai * 128 + wr * 64 + m * 16 + fr;
                bf16_t* rp = base + ((size_t)((b * 256 + cp) * 2 + s)) * T + t0 + wc * 32 + 8 * fq;
#pragma unroll
                for (int bj = 0; bj < 2; ++bj) st_bf16x8(rp + bj * 128, acc[ai][bj][m][0], acc[ai][bj][m][1]);
            }
    }
};
struct EpiFour {
    static constexpr bool PERM = true;
    bf16_t* O;
    __device__ __forceinline__ void operator()(const f32x4 (&acc)[2][2][4][2], const pg8::Unit& u, int wr, int wc, int fr, int fq) const {
        const int gi = u.pm, b = u.pn;
#pragma unroll
        for (int ai = 0; ai < 2; ++ai)
#pragma unroll
            for (int m = 0; m < 4; ++m) { const int t2 = ai * 128 + wr * 64 + m * 16 + fr;
                const int row = gi < 16 ? NCTX + b * SEQ + gi + 16 * t2 : b * CTXL + t2;
                bf16_t* rp = O + (size_t)row * D + wc * 32 + 8 * fq;
#pragma unroll
                for (int bj = 0; bj < 2; ++bj) st_bf16x8(rp + bj * 128, acc[ai][bj][m][0], acc[ai][bj][m][1]);
            }
    }
};
struct EpiY {
    static constexpr bool PERM = true;
    bf16_t* Y; int ldc;
    __device__ __forceinline__ void operator()(const f32x4 (&acc)[2][2][4][2], const pg8::Unit& u, int wr, int wc, int fr, int fq) const {
#pragma unroll
        for (int ai = 0; ai < 2; ++ai)
#pragma unroll
            for (int m = 0; m < 4; ++m) { bf16_t* rp = Y + (size_t)(u.pm * 256 + ai * 128 + wr * 64 + m * 16 + fr) * ldc + u.pn * 256 + wc * 64 + 8 * fq;
#pragma unroll
                for (int bj = 0; bj < 2; ++bj) st_bf16x8(rp + bj * 32, acc[ai][bj][m][0], acc[ai][bj][m][1]); }
    }
};
struct EpiSwiglu {
    static constexpr bool PERM = true;
    unsigned char* ACT; const float* bgu;
    __device__ __forceinline__ void operator()(const f32x4 (&acc)[2][2][4][2], const pg8::Unit& u, int wr, int wc, int fr, int fq) const {
        const int col = u.pn * 128 + wc * 32 + 8 * fq; const float* bb = bgu + (size_t)u.aux * 2048 + col;
        const f32x4 bg0 = *(const f32x4*)bb, bg1 = *(const f32x4*)(bb + 4), bu0 = *(const f32x4*)(bb + 1024) + 1.0f, bu1 = *(const f32x4*)(bb + 1028) + 1.0f;
#pragma unroll
        for (int ai = 0; ai < 2; ++ai)
#pragma unroll
            for (int m = 0; m < 4; ++m) {
                f32x4 o[2];
#pragma unroll
                for (int n = 0; n < 2; ++n) { const f32x4 sc4 = (f32x4){1.0f / WGU_SCALE, 1.0f / WGU_SCALE, 1.0f / WGU_SCALE, 1.0f / WGU_SCALE};
                    const f32x4 gg = __builtin_elementwise_fma(acc[ai][0][m][n], sc4, n ? bg1 : bg0), uu = __builtin_elementwise_fma(acc[ai][1][m][n], sc4, n ? bu1 : bu0);
#pragma unroll
                    for (int e = 0; e < 4; e += 2) {
                        const f32x2 gc = (f32x2){fminf(gg[e], 7.0f), fminf(gg[e + 1], 7.0f)}, uc1 = (f32x2){fminf(fmaxf(uu[e], -6.0f), 8.0f), fminf(fmaxf(uu[e + 1], -6.0f), 8.0f)};
                        const f32x2 t = gc * (-1.702f * LOG2E);
                        const f32x2 d = (f32x2){__builtin_amdgcn_exp2f(t.x), __builtin_amdgcn_exp2f(t.y)} + 1.0f;
                        const f32x2 r = (f32x2){__builtin_amdgcn_rcpf(d.x), __builtin_amdgcn_rcpf(d.y)};
                        const f32x2 res = uc1 * (gc * r); o[n][e] = res.x; o[n][e + 1] = res.y; } }
                u32x2 w; w.x = pk4_fp8(o[0][0], o[0][1], o[0][2], o[0][3]); w.y = pk4_fp8(o[1][0], o[1][1], o[1][2], o[1][3]);
                *(u32x2*)(ACT + ((size_t)(u.pm * 8 + u.pn) * 256 + (ai * 128 + wr * 64 + m * 16 + fr)) * 128 + wc * 32 + 8 * fq) = w;
            }
    }
};
struct EpiDown {
    static constexpr bool PERM = true;
    unsigned char* YB; const float* bd;
    __device__ __forceinline__ void operator()(const f32x4 (&acc)[2][2][4][2], const pg8::Unit& u, int wr, int wc, int fr, int fq) const {
        const int col0 = u.pn * 256 + wc * 64 + 16 * fq; const float* bb = bd + (size_t)u.aux * 1024 + col0;
        f32x4 bv[2][2];
#pragma unroll
        for (int bj = 0; bj < 2; ++bj)
#pragma unroll
            for (int n = 0; n < 2; ++n) bv[bj][n] = *(const f32x4*)(bb + bj * 8 + 4 * n);
#pragma unroll
        for (int ai = 0; ai < 2; ++ai)
#pragma unroll
            for (int m = 0; m < 4; ++m) { unsigned char* rp = YB + (size_t)(u.pm * 256 + ai * 128 + wr * 64 + m * 16 + fr) * D + col0;
                u32x4 w;
#pragma unroll
                for (int bj = 0; bj < 2; ++bj) { const f32x4 sc4 = (f32x4){1.0f / WD_SCALE, 1.0f / WD_SCALE, 1.0f / WD_SCALE, 1.0f / WD_SCALE};
                    const f32x4 a = __builtin_elementwise_fma(acc[ai][bj][m][0], sc4, bv[bj][0]), b = __builtin_elementwise_fma(acc[ai][bj][m][1], sc4, bv[bj][1]);
                    w[2 * bj] = pk4_fp8(a[0], a[1], a[2], a[3]); w[2 * bj + 1] = pk4_fp8(b[0], b[1], b[2], b[3]); }
                *(u32x4*)rp = w; }
    }
};

namespace att {
constexpr float THR = 8.0f;
__device__ __forceinline__ float max3f(float a, float b, float c) { float r; asm("v_max3_f32 %0, %1, %2, %3" : "=v"(r) : "v"(a), "v"(b), "v"(c)); return r; }
__device__ __forceinline__ float max2f(float a, float b) { float r; asm("v_max_f32_e32 %0, %1, %2" : "=v"(r) : "v"(a), "v"(b)); return r; }
template <int DV, int NK = 64> struct StV { u32x4 v[DV * NK / 4096]; };
template <int NK = 64> struct StK { u32x4 k[NK / 64]; };
template <int NK> __device__ __forceinline__ void load_k(StK<NK>& s, const bf16_t* K, int kp, int row0, int tid) {
#pragma unroll
    for (int i = 0; i < NK / 64; ++i) { const int idx = tid + 512 * i, key = idx >> 3, ch = idx & 7; s.k[i] = *(const u32x4*)(K + (size_t)(row0 + key) * kp + ch * 8); }
}
template <int NK> __device__ __forceinline__ void write_k(const StK<NK>& s, ldsp_t kb, int tid) {
#pragma unroll
    for (int i = 0; i < NK / 64; ++i) { const int idx = tid + 512 * i, key = idx >> 3, ch = idx & 7; *(LAS u32x4*)(kb + key * 128 + ((ch ^ ((key >> 1) & 7)) << 4)) = s.k[i]; }
}
template <int DV, int NK> __device__ __forceinline__ void load_v(StV<DV, NK>& s, const bf16_t* V, int vp, int row0, int tid) {
#pragma unroll
    for (int i = 0; i < DV * NK / 4096; ++i) { const int idx = tid + 512 * i, key = idx / (DV / 8), ch = idx % (DV / 8); s.v[i] = *(const u32x4*)(V + (size_t)(row0 + key) * vp + ch * 8); }
}
template <int DV, int NK> __device__ __forceinline__ void write_v(const StV<DV, NK>& s, ldsp_t vb, int tid) {
#pragma unroll
    for (int i = 0; i < DV * NK / 4096; ++i) { const int idx = tid + 512 * i, key = idx / (DV / 8), ch = idx % (DV / 8);
        *(LAS u32x4*)(vb + ((key >> 3) * (DV / 32) + (ch >> 2)) * 512 + (key & 7) * 64 + (ch & 3) * 16) = s.v[i]; }
}
__device__ __forceinline__ s16x4 vtr(ldsp_t p) { return __builtin_bit_cast(s16x4, __builtin_amdgcn_ds_read_tr16_b64_v4i16((LAS s16x4*)p)); }
__device__ __forceinline__ void qk(f32x16& p0, f32x16& p1, ldsp_t kb, const bf16x8 (&qf)[4], const f32x16& cinit, int koff0, int koff1, int kx0, int kx1, int h) {
    bf16x8 a0[4], a1[4];
#pragma unroll
    for (int s = 0; s < 4; ++s) { a0[s] = *(const LAS bf16x8*)(kb + koff0 + (((2 * s + h) ^ kx0) << 4)); a1[s] = *(const LAS bf16x8*)(kb + koff1 + (((2 * s + h) ^ kx1) << 4)); }
    __builtin_amdgcn_sched_barrier(0);
    p0 = __builtin_amdgcn_mfma_f32_32x32x16_bf16(a0[0], qf[0], cinit, 0, 0, 0); p1 = __builtin_amdgcn_mfma_f32_32x32x16_bf16(a1[0], qf[0], cinit, 0, 0, 0);
#pragma unroll
    for (int s = 1; s < 4; ++s) { p0 = __builtin_amdgcn_mfma_f32_32x32x16_bf16(a0[s], qf[s], p0, 0, 0, 0); p1 = __builtin_amdgcn_mfma_f32_32x32x16_bf16(a1[s], qf[s], p1, 0, 0, 0); }
}
__device__ __forceinline__ float rowmax(const f32x16& p0, const f32x16& p1) {
    float a = max3f(p0[0], p0[1], p1[0]), b = max3f(p0[2], p0[3], p1[1]); a = max3f(a, p1[2], p1[3]);
#pragma unroll
    for (int i = 4; i < 16; i += 4) { a = max3f(a, p0[i], p0[i + 1]); b = max3f(b, p0[i + 2], p0[i + 3]); a = max3f(a, p1[i], p1[i + 1]); b = max3f(b, p1[i + 2], p1[i + 3]); }
    float m = max2f(a, b), m2 = m; swap32(m, m2); return max2f(m, m2);
}
#define ATT_SB() __builtin_amdgcn_sched_barrier(0)
template <int DV, bool WINDOW>
__device__ __forceinline__ void sm_head(f32x16& p0, f32x16& p1, float& m, float& l, f32x16& negm, f32x16 (&o)[DV / 32], bool masked, int kp0, int qpos, int h) {
    if (WINDOW && masked) {
        const int wq0 = __builtin_amdgcn_readfirstlane(qpos - (int)(__builtin_amdgcn_mbcnt_hi(~0u, __builtin_amdgcn_mbcnt_lo(~0u, 0u)) & 31u));
        const bool inside = (kp0 >= wq0 + 31 - 128) && (kp0 + 63 <= wq0 + 128);
        const bool outside = (kp0 > wq0 + 31 + 128) || (kp0 + 63 < wq0 - 128);
        if (outside) {
#pragma unroll
            for (int i = 0; i < 16; ++i) { p0[i] = -1e30f; p1[i] = -1e30f; }
        } else if (!inside) {
#pragma unroll
            for (int i = 0; i < 16; ++i) { const int kpos = kp0 + (i & 3) + 8 * (i >> 2) + 4 * h; const int d0 = qpos - kpos, d1 = d0 - 32;
                if (d0 > 128 || d0 < -128) p0[i] = -1e30f; if (d1 > 128 || d1 < -128) p1[i] = -1e30f; }
        }
    }
    const float mx = rowmax(p0, p1);
    if (__any(mx > THR)) {
        const float inc = fmaxf(mx, 0.f), alpha = __builtin_amdgcn_exp2f(-inc);
        m += inc; l *= alpha;
#pragma unroll
        for (int c = 0; c < DV / 32; ++c)
#pragma unroll
            for (int i = 0; i < 16; ++i) o[c][i] *= alpha;
#pragma unroll
        for (int i = 0; i < 16; ++i) { p0[i] -= inc; p1[i] -= inc; negm[i] = -m; }
    }
}
template <int DV, bool PIPE>
__device__ __forceinline__ void fused_body(f32x16& c0, f32x16& c1, f32x16& n0, f32x16& n1, ldsp_t kbn, ldsp_t vb, const bf16x8 (&qf)[4], const f32x16& negm, f32x16 (&o)[DV / 32], float& l,
                                           int koff0, int koff1, int kx0, int kx1, int h, int voff) {
    constexpr int NC = DV / 32;
#define ATT_LDK(half, s) (*(const LAS bf16x8*)(kbn + ((half) ? koff1 : koff0) + (((2 * (s) + h) ^ ((half) ? kx1 : kx0)) << 4)))
#define ATT_EXP8(p, i0) do { _Pragma("unroll") for (int i_ = 0; i_ < 8; ++i_) { p[(i0) + i_] = __builtin_amdgcn_exp2f(p[(i0) + i_]); ls += p[(i0) + i_]; } } while (0)
#define ATT_LDV(dst, ks) do { _Pragma("unroll") for (int c_ = 0; c_ < NC; ++c_) { const int kb8_ = 4 * ((ks) >> 1) + 2 * ((ks) & 1); \
        dst[c_][0] = vtr(vb + voff + ((kb8_ + 0) * NC + c_) * 512); dst[c_][1] = vtr(vb + voff + ((kb8_ + 1) * NC + c_) * 512); } } while (0)
#define ATT_PV(vf, pfv) do { _Pragma("unroll") for (int c_ = 0; c_ < NC; ++c_) { \
        const bf16x8 v_ = (bf16x8){vf[c_][0][0], vf[c_][0][1], vf[c_][0][2], vf[c_][0][3], vf[c_][1][0], vf[c_][1][1], vf[c_][1][2], vf[c_][1][3]}; \
        o[c_] = __builtin_amdgcn_mfma_f32_32x32x16_bf16(v_, pfv, o[c_], 0, 0, 0); } } while (0)
#define ATT_PACK(p, i0) __builtin_bit_cast(bf16x8, (u32x4){cvt_pk_bf16(p[(i0)], p[(i0) + 1]), cvt_pk_bf16(p[(i0) + 2], p[(i0) + 3]), cvt_pk_bf16(p[(i0) + 4], p[(i0) + 5]), cvt_pk_bf16(p[(i0) + 6], p[(i0) + 7])})
    float ls = 0.f;
    s16x4 va[NC][2], vb2[NC][2];
    if constexpr (PIPE) {
    bf16x8 ka0 = ATT_LDK(0, 0), ka1 = ATT_LDK(1, 0), kb0 = ATT_LDK(0, 1), kb1 = ATT_LDK(1, 1), kc0, kc1;
    s16x4 vc2[NC][2];
    ATT_SB();
    kc0 = ATT_LDK(0, 2); kc1 = ATT_LDK(1, 2);
    n0 = __builtin_amdgcn_mfma_f32_32x32x16_bf16(ka0, qf[0], negm, 0, 0, 0); n1 = __builtin_amdgcn_mfma_f32_32x32x16_bf16(ka1, qf[0], negm, 0, 0, 0);
    ATT_EXP8(c0, 0);
    ATT_SB();
    ka0 = ATT_LDK(0, 3); ka1 = ATT_LDK(1, 3);
    n0 = __builtin_amdgcn_mfma_f32_32x32x16_bf16(kb0, qf[1], n0, 0, 0, 0); n1 = __builtin_amdgcn_mfma_f32_32x32x16_bf16(kb1, qf[1], n1, 0, 0, 0);
    ATT_EXP8(c0, 8);
    ATT_SB();
    ATT_LDV(va, 0);
    n0 = __builtin_amdgcn_mfma_f32_32x32x16_bf16(kc0, qf[2], n0, 0, 0, 0); n1 = __builtin_amdgcn_mfma_f32_32x32x16_bf16(kc1, qf[2], n1, 0, 0, 0);
    ATT_EXP8(c1, 0);
    ATT_SB();
    ATT_LDV(vb2, 1);
    n0 = __builtin_amdgcn_mfma_f32_32x32x16_bf16(ka0, qf[3], n0, 0, 0, 0); n1 = __builtin_amdgcn_mfma_f32_32x32x16_bf16(ka1, qf[3], n1, 0, 0, 0);
    ATT_EXP8(c1, 8);
    ATT_SB();
    l += ls;
    { const bf16x8 pf = ATT_PACK(c0, 0); ATT_LDV(vc2, 2); ATT_PV(va, pf); } ATT_SB();
    { const bf16x8 pf = ATT_PACK(c0, 8); ATT_LDV(va, 3); ATT_PV(vb2, pf); } ATT_SB();
    { const bf16x8 pf = ATT_PACK(c1, 0); ATT_PV(vc2, pf); } ATT_SB();
    { const bf16x8 pf = ATT_PACK(c1, 8); ATT_PV(va, pf); } ATT_SB();
    } else {
    ATT_LDV(va, 0); ATT_EXP8(c0, 0);
    ATT_SB();
    { const bf16x8 pf = ATT_PACK(c0, 0); ATT_LDV(vb2, 1); ATT_PV(va, pf); ATT_EXP8(c0, 8); } ATT_SB();
    { const bf16x8 pf = ATT_PACK(c0, 8); ATT_LDV(va, 2); ATT_PV(vb2, pf); ATT_EXP8(c1, 0); } ATT_SB();
    { const bf16x8 pf = ATT_PACK(c1, 0); ATT_LDV(vb2, 3); ATT_PV(va, pf); ATT_EXP8(c1, 8); } ATT_SB();
    { const bf16x8 pf = ATT_PACK(c1, 8); ATT_PV(vb2, pf); } ATT_SB();
    l += ls;
    }
#undef ATT_LDK
#undef ATT_EXP8
#undef ATT_LDV
#undef ATT_PV
#undef ATT_PACK
}
template <int DV, bool WINDOW, bool PIPE = true, int NK = 64>
__device__ __forceinline__ void attn_pass(ldsp_t lds, const bf16x8 (&qf)[4], const bf16_t* K, int kp, const bf16_t* V, int vp,
                                          int s0_row, int s0_tiles, int s1_row, int s1_tiles, int qpos, int s1_kpos0,
                                          f32x16 (&o)[DV / 32], float& m_out, float& l_out, int tid, int lane) {
    const int r = lane & 31, h = lane >> 5;
    const int nt = s0_tiles + s1_tiles;
#pragma unroll
    for (int c = 0; c < DV / 32; ++c)
#pragma unroll
        for (int i = 0; i < 16; ++i) o[c][i] = 0.f;
    float m, l = 0.f;
    const int koff0 = r * 128, koff1 = (32 + r) * 128, kx0 = (r >> 1) & 7, kx1 = ((32 + r) >> 1) & 7;
    const int i16 = lane & 15, q4 = i16 >> 2, p4 = i16 & 3, rhalf = (lane >> 4) & 1;
    const int voff = (4 * h + q4) * 64 + (16 * rhalf + 4 * p4) * 2;
    constexpr int SUB = NK / 64, KBB = NK * 128, VBB = NK * DV * 2, KR = (PIPE && SUB > 1) ? 3 : 2;
    const int ns = nt / SUB;
#define ATT_ROW(st) ((st) * SUB < s0_tiles ? s0_row + NK * (st) : s1_row + NK * ((st) - s0_tiles / SUB))
#define ATT_KB(b) (lds + (b) * KBB)
#define ATT_VB(b) (lds + KR * KBB + (b) * VBB)
    StK<NK> stk; StV<DV, NK> stv;
    load_k<NK>(stk, K, kp, ATT_ROW(0), tid); load_v<DV, NK>(stv, V, vp, ATT_ROW(0), tid); write_k<NK>(stk, ATT_KB(0), tid); write_v<DV, NK>(stv, ATT_VB(0), tid);
    if (PIPE && ns > 1) { load_k<NK>(stk, K, kp, ATT_ROW(1), tid); write_k<NK>(stk, ATT_KB(1), tid); }
    __syncthreads();
    f32x16 pA0, pA1, negm;
#pragma unroll
    for (int i = 0; i < 16; ++i) negm[i] = 0.f;
    qk(pA0, pA1, ATT_KB(0), qf, negm, koff0, koff1, kx0, kx1, h);
    { m = rowmax(pA0, pA1);
#pragma unroll
      for (int i = 0; i < 16; ++i) { pA0[i] -= m; pA1[i] -= m; negm[i] = -m; } }
    if constexpr (PIPE) {
    f32x16 pB0, pB1;
#define ATT_SUBT(c0, c1, n0, n1, st, j, par) do { const int t_ = (st) * SUB + (j); \
        sm_head<DV, WINDOW>(c0, c1, m, l, negm, o, t_ >= s0_tiles, s1_kpos0 + 64 * (t_ - s0_tiles), qpos, h); \
        fused_body<DV, true>(c0, c1, n0, n1, ((j) + 1 < SUB ? ATT_KB(kc) + ((j) + 1) * 8192 : ATT_KB(kn)), ATT_VB(par) + (j) * (DV * 128), qf, negm, o, l, koff0, koff1, kx0, kx1, h, voff); } while (0)
#define ATT_STEP(st, par) do { \
        const bool has1_ = (st) + 1 < ns, has2_ = (st) + 2 < ns; \
        const int kn = (kc + 1 == KR) ? 0 : kc + 1, kw = (kn + 1 == KR) ? 0 : kn + 1;     \
        if (has2_) load_k<NK>(stk, K, kp, ATT_ROW((st) + 2), tid); \
        if (has1_) load_v<DV, NK>(stv, V, vp, ATT_ROW((st) + 1), tid); \
        if constexpr (SUB == 1) { if ((par) == 0) ATT_SUBT(pA0, pA1, pB0, pB1, st, 0, par); else ATT_SUBT(pB0, pB1, pA0, pA1, st, 0, par); } \
        else { ATT_SUBT(pA0, pA1, pB0, pB1, st, 0, par); ATT_SUBT(pB0, pB1, pA0, pA1, st, 1, par); } \
        if (has2_) write_k<NK>(stk, ATT_KB(kw), tid); \
        if (has1_) write_v<DV, NK>(stv, ATT_VB(1 - (par)), tid); \
        __syncthreads(); kc = kn; } while (0)
    int kc = 0;
    for (int st = 0; st < ns; st += 2) {
        ATT_STEP(st, 0);
        if (st + 1 < ns) ATT_STEP(st + 1, 1);
    }
#undef ATT_SUBT
    } else {
#define ATT_STEP1(t, par) do { \
        const bool has1_ = (t) + 1 < nt; \
        if (has1_) { load_k<NK>(stk, K, kp, ATT_ROW((t) + 1), tid); load_v<DV, NK>(stv, V, vp, ATT_ROW((t) + 1), tid); } \
        if ((t) > 0) qk(pA0, pA1, ATT_KB(par), qf, negm, koff0, koff1, kx0, kx1, h); \
        sm_head<DV, WINDOW>(pA0, pA1, m, l, negm, o, (t) >= s0_tiles, s1_kpos0 + 64 * ((t) - s0_tiles), qpos, h); \
        fused_body<DV, false>(pA0, pA1, pA0, pA1, ATT_KB(par), ATT_VB(par), qf, negm, o, l, koff0, koff1, kx0, kx1, h, voff); \
        if (has1_) { write_k<NK>(stk, ATT_KB(1 - (par)), tid); write_v<DV, NK>(stv, ATT_VB(1 - (par)), tid); } \
        __syncthreads(); } while (0)
    static_assert(PIPE || NK == 64, "the unpipelined order walks 64-key steps");
    for (int t = 0; t < nt; t += 2) {
        ATT_STEP1(t, 0);
        if (t + 1 < nt) ATT_STEP1(t + 1, 1);
    }
#undef ATT_STEP1
    }
#undef ATT_STEP
#undef ATT_ROW
#undef ATT_KB
#undef ATT_VB
    m_out = m; { float la = l, lb = l; swap32(la, lb); l_out = la + lb; }
}
__device__ __forceinline__ void load_q(bf16x8 (&qf)[4], const bf16_t* Qrow, int h) {
#pragma unroll
    for (int s = 0; s < 4; ++s) qf[s] = *(const bf16x8*)(Qrow + 16 * s + 8 * h);
}
__device__ __forceinline__ void store_pair(bf16_t* Orow, int dvbase, f32x4 a0, f32x4 a1, int h) {
    u32x2 w0, w1; w0.x = cvt_pk_bf16(a0[0], a0[1]); w0.y = cvt_pk_bf16(a0[2], a0[3]); w1.x = cvt_pk_bf16(a1[0], a1[1]); w1.y = cvt_pk_bf16(a1[2], a1[3]);
    { auto rx = __builtin_amdgcn_permlane32_swap(w0.x, w1.x, false, false); w0.x = rx[0]; w1.x = rx[1]; auto ry = __builtin_amdgcn_permlane32_swap(w0.y, w1.y, false, false); w0.y = ry[0]; w1.y = ry[1]; }
    const u32x4 out = (u32x4){w0.x, w0.y, w1.x, w1.y}; (void)h;
    *(u32x4*)(Orow + dvbase + 8 * h) = out;
}
template <int DV> __device__ __forceinline__ void store_o(const f32x16 (&o)[DV / 32], float scale, bf16_t* Orow, int h) {
#pragma unroll
    for (int c = 0; c < DV / 32; ++c)
#pragma unroll
        for (int g = 0; g < 4; g += 2)
            store_pair(Orow, 32 * c + 8 * g, (f32x4){o[c][4 * g] * scale, o[c][4 * g + 1] * scale, o[c][4 * g + 2] * scale, o[c][4 * g + 3] * scale},
                       (f32x4){o[c][4 * g + 4] * scale, o[c][4 * g + 5] * scale, o[c][4 * g + 6] * scale, o[c][4 * g + 7] * scale}, h);
}
}

template <int PERMKIND> __device__ __forceinline__ int dest_row(int n) {
    if (PERMKIND == 1) { const int tile = n >> 8, nl = n & 255, wc = nl >> 6, bj = (nl >> 5) & 1, r5 = nl & 31; return (tile << 8) + 128 * bj + 32 * wc + r5; }
    if (PERMKIND == 2) { return n < 1024 ? (((n >> 7) << 8) + (n & 127)) : ((((n - 1024) >> 7) << 8) + 128 + ((n - 1024) & 127)); }
    return n;
}
template <int PERMKIND> __device__ __forceinline__ int dest_col(int n) {
    if (PERMKIND == 4) { const int tile = n >> 8, o = n & 255, wc = o >> 6, fq = (o >> 4) & 3, bj = (o >> 3) & 1, low3 = o & 7; return (tile << 8) + 128 * bj + 32 * wc + 8 * fq + low3; }
    return dest_row<PERMKIND>(n & ~31) + (n & 31);
}
template <int PERMKIND> __device__ __forceinline__ int r_off(int n0, int r) { return dest_row<PERMKIND>(n0 + (r & 32)) - dest_row<PERMKIND>(n0) + (r & 31); }
template <int PERMKIND> __device__ __forceinline__ void p0_transpose_item(const float* W, int K, int ldw, int n_src0, int N, bf16_t* WT, LAS float* scr, int item, int lane, int nperm = 0) {
    const int nblk = N / 32, kb = item / nblk, nb = item % nblk, k0 = 64 * kb, n0 = 32 * nb;
#pragma unroll 8
    for (int i = 0; i < 32; ++i) { const int kk = 2 * i + (lane >> 5); scr[kk * 33 + (lane & 31)] = W[(size_t)(k0 + kk) * ldw + n_src0 + n0 + (lane & 31)]; }
    LDS_WAIT(); asm volatile("" ::: "memory");
    const int c = lane & 7; const int dr0 = dest_row<PERMKIND>(n0);
#pragma unroll
    for (int j = 0; j < 4; ++j) { const int n = (lane >> 3) + 8 * j; const LAS float* s = scr + (8 * c) * 33 + n;
        u32x4 o; o.x = pk2(s[0 * 33], s[1 * 33]); o.y = pk2(s[2 * 33], s[3 * 33]); o.z = pk2(s[4 * 33], s[5 * 33]); o.w = pk2(s[6 * 33], s[7 * 33]);
        const int slot = (n0 < nperm) ? (8 * ((n >> 2) & 3) + 4 * (n >> 4) + (n & 3)) : n;
        *(u32x4*)(WT + (size_t)(dr0 + slot) * K + k0 + 8 * c) = o; }
    LDS_WAIT(); asm volatile("" ::: "memory");
}
template <int PERMKIND> __device__ __forceinline__ void t8_step(const float* W, int K, int N, unsigned char* WT8, float scale, LAS unsigned* scr, int k0, int n0, int lane) {
    float v[128];
    const float* wp = W + (size_t)k0 * N + n0 + lane;
#pragma unroll
    for (int i = 0; i < 128; ++i) v[i] = wp[(size_t)i * N];
#pragma unroll
    for (int g = 0; g < 32; ++g) scr[lane * 33 + g] = pk4_fp8(v[4 * g] * scale, v[4 * g + 1] * scale, v[4 * g + 2] * scale, v[4 * g + 3] * scale);
    LDS_WAIT(); asm volatile("" ::: "memory");
    const int q = lane & 7;
#pragma unroll
    for (int j = 0; j < 8; ++j) { const int r = (lane >> 3) + 8 * j; u32x4 o; o.x = scr[r * 33 + 4 * q]; o.y = scr[r * 33 + 4 * q + 1]; o.z = scr[r * 33 + 4 * q + 2]; o.w = scr[r * 33 + 4 * q + 3];
        *(u32x4*)(WT8 + (size_t)dest_col<PERMKIND>(n0 + r) * K + k0 + 16 * q) = o; }
    LDS_WAIT(); asm volatile("" ::: "memory");
}
template <int PERMKIND> __device__ __forceinline__ void t8_stream(const float* W, int nmat, int K, int N, int ksplit, unsigned char* WT8, float scale, LAS float* scrf, int gw, int NGW, int lane) {
    const int spm = (N / 64) * ksplit, total = nmat * spm, klen = K / ksplit;
    for (int st = gw; st < total; st += NGW) {
        const int mi = st / spm, r = st % spm, nb = r / ksplit, kh = r % ksplit;
        for (int k0 = kh * klen; k0 < (kh + 1) * klen; k0 += 128)
            t8_step<PERMKIND>(W + (size_t)mi * K * N, K, N, WT8 + (size_t)mi * K * N, scale, (LAS unsigned*)scrf, k0, 64 * nb, lane);
    }
}
__device__ __forceinline__ float silu(float x) { return x / (1.0f + __expf(-x)); }

__device__ __forceinline__ void p0_prologue(Frame& F, const KArgs& A) {
    const int gw = F.vcu * 8 + F.wave, NGW = F.G * 8;
    if (F.vcu >= 64 || F.G < 256) {
        const float* c = A.in(1); const float* cc = A.in(3); const float* mw = A.in(4); const float* mb = A.in(5);
        float* modv = WSP(float, WS_MODV);
        LAS float* red = (LAS float*)F.lds;
        LAS float* sl = (LAS float*)(F.lds + 16384);
        for (int i = F.tid; i < 5 * D; i += 512) sl[i] = silu(i < 4 * D ? c[i] : cc[i - 4 * D]);
        __syncthreads();
        const int first = F.G < 256 ? F.vcu : F.vcu - 64, step = F.G < 256 ? F.G : F.G - 64;
        for (int it = first; it < 2 * (NMOD / 64); it += step) {
            const int l = it / (NMOD / 64), col = (it % (NMOD / 64)) * 64 + F.lane;
            float a[5] = {0.f, 0.f, 0.f, 0.f, 0.f};
            const float* wp = mw + (size_t)l * D * NMOD + col;
#pragma unroll 16
            for (int k = F.wave * 128; k < F.wave * 128 + 128; ++k) {
                const float w = wp[(size_t)k * NMOD];
#pragma unroll
                for (int r = 0; r < 5; ++r) a[r] += sl[r * D + k] * w;
            }
#pragma unroll
            for (int r = 0; r < 5; ++r) red[(F.wave * 5 + r) * 64 + F.lane] = a[r];
            __syncthreads();
            if (F.wave < 5) { float s2 = mb[l * NMOD + col];
#pragma unroll
                for (int w = 0; w < 8; ++w) s2 += red[(w * 5 + F.wave) * 64 + F.lane];
                modv[((size_t)l * 5 + F.wave) * NMOD + col] = s2; }
            __syncthreads();
        }
    }
    if (gw < 16) { const int idx = gw * 64 + F.lane; const int pos = idx >> 4, f = idx & 15;
        const float inv = powf(10000.0f, -(float)f / 16.0f); const float ang = (float)pos * inv;
        WSP(float, WS_ROPE)[idx] = cosf(ang); WSP(float, WS_ROPE)[1024 + idx] = sinf(ang); }
    {
        bf16_t* A = WSP(bf16_t, WS_ADFT);
        for (int idx = gw * 64 + F.lane; idx < 17 * 256 * 256; idx += NGW * 64) {
            const int gi = idx >> 16, t2p = (idx >> 8) & 255, t2 = idx & 255;
            float cv, sv;
            if (gi < 16) { const int tp = gi + 16 * t2p; const int ph = (t2 * tp) & 4095; const float ang = (float)ph * (6.283185307179586f / 4096.0f); cv = cosf(ang) * (1.0f / 64.0f); sv = sinf(ang) * (1.0f / 64.0f); }
            else { const int ph = (t2 * t2p) & 255; const float ang = (float)ph * (6.283185307179586f / 256.0f); cv = cosf(ang) * (1.0f / 16.0f); sv = -sinf(ang) * (1.0f / 16.0f); }
            A[((size_t)gi * 256 + t2p) * 512 + t2] = (bf16_t)f2bf(cv); A[((size_t)gi * 256 + t2p) * 512 + 256 + t2] = (bf16_t)f2bf(sv);
        }
    }
    {
        const float* W = A.in(8); bf16_t* WF = WSP(bf16_t, WS_WF);
        const float cs = cosf((float)F.lane * (6.283185307179586f / 64.0f)), sn = sinf((float)F.lane * (6.283185307179586f / 64.0f));
        for (int it = gw; it < 4 * 128; it += NGW) {
            const int g = it >> 7, k0 = (it & 127) * 8;
            float ac[8], as[8];
#pragma unroll
            for (int kk = 0; kk < 8; ++kk) { ac[kk] = 0.f; as[kk] = 0.f; }
            float wv[8];
#pragma unroll
            for (int kk = 0; kk < 8; ++kk) wv[kk] = W[(size_t)(k0 + kk) * 1536 + 64 * g + F.lane];
            for (int c = 0; c < 64; ++c) {
                const int ph = (c * F.lane) & 63;
                const float cv = __shfl(cs, ph), sv = __shfl(sn, ph);
#pragma unroll
                for (int kk = 0; kk < 8; ++kk) { const float w = __shfl(wv[kk], c); ac[kk] += w * cv; as[kk] += w * sv; }
            }
            u32x4 oc, os;
            oc.x = pk2(ac[0] * 0.125f, ac[1] * 0.125f); oc.y = pk2(ac[2] * 0.125f, ac[3] * 0.125f); oc.z = pk2(ac[4] * 0.125f, ac[5] * 0.125f); oc.w = pk2(ac[6] * 0.125f, ac[7] * 0.125f);
            os.x = pk2(as[0] * 0.125f, as[1] * 0.125f); os.y = pk2(as[2] * 0.125f, as[3] * 0.125f); os.z = pk2(as[4] * 0.125f, as[5] * 0.125f); os.w = pk2(as[6] * 0.125f, as[7] * 0.125f);
            *(u32x4*)(WF + (size_t)(64 * g + F.lane) * D + k0) = oc;
            *(u32x4*)(WF + (size_t)(256 + 64 * g + F.lane) * D + k0) = os;
        }
    }
    {
        LAS float* scr = (LAS float*)(F.lds + F.wave * 16384);
        constexpr int I_ABI = 16 * 40, I_SQ = 16 * 32, I_CDI = 16 * 72, I_GU = 16 * 64, I_DN = 16 * 32;
        constexpr int NSMALL = I_ABI + I_SQ + I_CDI + I_SQ;
        for (int it = gw; it < NSMALL; it += NGW) {
            int r = it;
            if (r < I_ABI) { p0_transpose_item<1>(A.in(8), D, 1536, 256, 1280, WSP(bf16_t, WS_WABI), scr, r, F.lane, 1024); continue; } r -= I_ABI;
            if (r < I_SQ) { p0_transpose_item<1>(A.in(10), D, D, 0, D, WSP(bf16_t, WS_WABO), scr, r, F.lane); continue; } r -= I_SQ;
            if (r < I_CDI) { p0_transpose_item<1>(A.in(11), D, CD_N, 0, CD_N, WSP(bf16_t, WS_WCDI), scr, r, F.lane, 1664); continue; } r -= I_CDI;
            p0_transpose_item<1>(A.in(16), D, D, 0, D, WSP(bf16_t, WS_WCDO), scr, r, F.lane);
        }
        t8_stream<2>(A.in(19), 32, D, 2048, 2, WSP(unsigned char, WS_WGU), WGU_SCALE, scr, gw, NGW, F.lane);
        t8_stream<4>(A.in(21), 32, FF, D, 4, WSP(unsigned char, WS_WD), WD_SCALE, scr, gw, NGW, F.lane);
    }
}

constexpr int BG_GU = 32 * 32 * 8, BG_DN = 32 * 16 * 8, BG_TOTAL = BG_GU + BG_DN, BG_HOLD = 1024;
constexpr int BG_P2 = 0, BG_P5 = BG_P2 + 36 * 8 * 3, BG_P11 = BG_P5 + 240 * 8 * 2, BG_P9 = BG_P11 + 156 * 8 * 3;
__device__ __forceinline__ void bg_step(Frame& F, const KArgs& A, int s) {
    LAS unsigned* scr = (LAS unsigned*)(F.lds + F.wave * 16384);
    if (s < BG_GU) { const int mi = 32 + (s >> 8), k0 = ((s >> 5) & 7) * 128, nb = s & 31;
        t8_step<2>(A.in(19) + (size_t)mi * D * 2048, D, 2048, WSP(unsigned char, WS_WGU) + (size_t)mi * D * 2048, WGU_SCALE, scr, k0, 64 * nb, F.lane); }
    else { const int q = s - BG_GU; const int mi = 32 + (q >> 7), k0 = ((q >> 4) & 7) * 128, nb = q & 15;
        t8_step<4>(A.in(21) + (size_t)mi * FF * D, FF, D, WSP(unsigned char, WS_WD) + (size_t)mi * FF * D, WD_SCALE, scr, k0, 64 * nb, F.lane); }
}
__device__ __forceinline__ void bg_range(Frame& F, const KArgs& A, int base, int first_vcu, int n) {
    const int s0 = base + ((F.vcu - first_vcu) * 8 + F.wave) * n;
    for (int i = 0; i < n; ++i) if (s0 + i < BG_TOTAL) bg_step(F, A, s0 + i);
}
__device__ __forceinline__ int bg_moe_idle(int T1, int nN, int G) { const int rem = (T1 * nN) % G; return rem; }

__device__ __forceinline__ void ld_row(f32x4 (&v)[4], const float* p, int lane) {
#pragma unroll
    for (int j = 0; j < 4; ++j) v[j] = *((const f32x4*)p + lane + 64 * j);
}
__device__ __forceinline__ void ld_row_bf16(f32x4 (&v)[4], const bf16_t* p, int lane) {
#pragma unroll
    for (int j = 0; j < 4; ++j) { const u32x2 w = *((const u32x2*)p + lane + 64 * j); v[j] = (f32x4){bf2f(w.x & 0xffffu), bf2f(w.x >> 16), bf2f(w.y & 0xffffu), bf2f(w.y >> 16)}; }
}
__device__ __forceinline__ void st_row(float* p, const f32x4 (&v)[4], int lane) {
#pragma unroll
    for (int j = 0; j < 4; ++j) *((f32x4*)p + lane + 64 * j) = v[j];
}
__device__ __forceinline__ void st_row_bf16(bf16_t* p, const f32x4 (&v)[4], int lane) {
#pragma unroll
    for (int j = 0; j < 4; ++j) { u32x2 w; w.x = pk2(v[j][0], v[j][1]); w.y = pk2(v[j][2], v[j][3]); *((u32x2*)p + lane + 64 * j) = w; }
}
__device__ __forceinline__ void st_row_fp8(unsigned char* p, const f32x4 (&v)[4], int lane) {
#pragma unroll
    for (int j = 0; j < 4; ++j) *((unsigned*)p + lane + 64 * j) = pk4_fp8(v[j][0], v[j][1], v[j][2], v[j][3]);
}
__device__ __forceinline__ void layernorm_row(f32x4 (&v)[4], const float* g, const float* b, int lane) {
    float s = 0.f;
#pragma unroll
    for (int j = 0; j < 4; ++j) s += (v[j][0] + v[j][1]) + (v[j][2] + v[j][3]);
    const float mean = wave_sum(s) * (1.0f / D); float s2 = 0.f;
#pragma unroll
    for (int j = 0; j < 4; ++j) { v[j] = v[j] - mean; s2 += (v[j][0] * v[j][0] + v[j][1] * v[j][1]) + (v[j][2] * v[j][2] + v[j][3] * v[j][3]); }
    const float rstd = 1.0f / sqrtf(wave_sum(s2) * (1.0f / D) + LN_EPS);
    f32x4 gg[4], bb[4]; ld_row(gg, g, lane); ld_row(bb, b, lane);
#pragma unroll
    for (int j = 0; j < 4; ++j) v[j] = v[j] * rstd * gg[j] + bb[j];
}
__device__ __forceinline__ int row_bi(int row) { return row < NCTX ? 4 : ((row - NCTX) >> 12); }
__device__ __forceinline__ const float* x_in_row(const KArgs& A, int row) { return row < NCTX ? A.in(2) + (size_t)row * D : A.in(0) + (size_t)(row - NCTX) * D; }

__device__ __forceinline__ void p_modulate0(Frame& F, const KArgs& A) {
    const int gw = F.vcu * 8 + F.wave, NGW = F.G * 8;
    const float* modv = WSP(float, WS_MODV); bf16_t* H = WSP(bf16_t, WS_H);
    for (int row = gw; row < NROW; row += NGW) {
        const float* mv = modv + (size_t)row_bi(row) * NMOD;
        f32x4 x[4], sh[4], sc[4]; ld_row(x, x_in_row(A, row), F.lane); ld_row(sh, mv, F.lane); ld_row(sc, mv + D, F.lane);
#pragma unroll
        for (int j = 0; j < 4; ++j) x[j] = x[j] * (1.0f + sc[j]) + sh[j];
        st_row_bf16(H + (size_t)row * D, x, F.lane);
    }
}

__device__ __forceinline__ void p_fourier1(Frame& F) {
    constexpr float C16[16] = {1.0f, 0.92387953251f, 0.70710678119f, 0.38268343237f, 0.0f, -0.38268343237f, -0.70710678119f, -0.92387953251f, -1.0f, -0.92387953251f, -0.70710678119f, -0.38268343237f, 0.0f, 0.38268343237f, 0.70710678119f, 0.92387953251f};
    const bf16_t* GT = WSP(bf16_t, WS_GT); bf16_t* YF = WSP(bf16_t, WS_YF);
    const int nthreads = F.G * 512;
    for (int idx = F.vcu * 512 + F.tid; idx < 4 * 256 * 256; idx += nthreads) {
        const int bc = idx >> 8, t2 = idx & 255;
        float gc[16], gs[16];
#pragma unroll
        for (int t1 = 0; t1 < 16; ++t1) { gc[t1] = bf2f(GT[((size_t)bc * 2 + 0) * SEQ + 256 * t1 + t2]); gs[t1] = bf2f(GT[((size_t)bc * 2 + 1) * SEQ + 256 * t1 + t2]); }
#pragma unroll
        for (int tp = 0; tp < 16; ++tp) { float yr = 0.f, yi = 0.f;
#pragma unroll
            for (int t1 = 0; t1 < 16; ++t1) { const float cv = C16[(t1 * tp) & 15], sv = C16[((t1 * tp) + 12) & 15];
                yr += gc[t1] * cv - gs[t1] * sv; yi -= gc[t1] * sv + gs[t1] * cv; }
            YF[((size_t)tp * 1024 + bc) * 512 + t2] = (bf16_t)f2bf(yr); YF[((size_t)tp * 1024 + bc) * 512 + 256 + t2] = (bf16_t)f2bf(yi); }
    }
}

__device__ __forceinline__ void p_attn0(Frame& F, const KArgs& A) {
    const bf16_t* P = WSP(bf16_t, WS_PB); bf16_t* O = WSP(bf16_t, WS_O); const float* sink = A.in(9);
    const int r = F.lane & 31, h = F.lane >> 5;
    constexpr int NU_LAT = BATCH * 12 * 16, NU = NU_LAT + BATCH * 12;
    for (int u = F.vcu; u < NU; u += F.G) {
        int b, qh, qrow0, s1_row, s1_tiles, kpos0, qpos0;
        const bool lat = u < NU_LAT;
        if (lat) { const int i = u & 15; qh = (u >> 4) % 12; b = u / 192; qpos0 = 256 * i; qrow0 = NCTX + b * SEQ + qpos0;
            const int lo = qpos0 - 128 < 0 ? 0 : qpos0 - 128, hi = qpos0 + 384 > SEQ ? SEQ : qpos0 + 384; kpos0 = lo; s1_row = NCTX + b * SEQ + lo; s1_tiles = (hi - lo) >> 6; }
        else { const int v = u - NU_LAT; qh = v % 12; b = v / 12; qrow0 = b * CTXL; qpos0 = 0; s1_row = 0; s1_tiles = 0; kpos0 = 0; }
        const int kvh = qh / 3;
        bf16x8 qf[4]; att::load_q(qf, P + (size_t)(qrow0 + 32 * F.wave + r) * AB_N + 64 * qh, h);
        f32x16 o[2]; float m, l;
        const int wq0 = qpos0 + 32 * F.wave;
        if (lat) att::attn_pass<64, true, true, 128>(F.lds, qf, P + 768 + 64 * kvh, AB_N, P + 1024 + 64 * kvh, AB_N, b * CTXL, 4, s1_row, s1_tiles, wq0 + r, kpos0, o, m, l, F.tid, F.lane);
        else att::attn_pass<64, false, true, 128>(F.lds, qf, P + 768 + 64 * kvh, AB_N, P + 1024 + 64 * kvh, AB_N, b * CTXL, 4, 0, 0, 0, 0, o, m, l, F.tid, F.lane);
        const float sl = sink[qh] * LOG2E; const float m2 = fmaxf(m, sl), a = __builtin_amdgcn_exp2f(m - m2);
        const float lt = l * a + __builtin_amdgcn_exp2f(sl - m2);
        att::store_o<64>(o, a / lt, O + (size_t)(qrow0 + 32 * F.wave + r) * D + 256 + 64 * qh, h);
    }
}
__device__ __forceinline__ void p_attn1(Frame& F, const KArgs& A) {
    const bf16_t* P = WSP(bf16_t, WS_PB); bf16_t* O = WSP(bf16_t, WS_O);
    const int r = F.lane & 31, h = F.lane >> 5;
    float lam;
    { const float* lv = A.in(12); const float a = wave_sum(lv[F.lane] * lv[64 + F.lane]), b2 = wave_sum(lv[128 + F.lane] * lv[192 + F.lane]); lam = expf(a) - expf(b2) + LAMBDA_INIT1; }
    constexpr int NU_C = BATCH * 4 * 16, NU_D = BATCH * 8 * 16;
#ifndef ATTN_PROBE
#define ATTN_PROBE 0
#endif
    for (int rep_ = 0; rep_ < (ATTN_PROBE == 2 ? 2 : 1); ++rep_)
    for (int u = F.vcu; u < NU_C; u += F.G) {
        const int i = u & 15, c = (u >> 4) & 3, b = u >> 6;
        const int qrow = NCTX + b * SEQ + 256 * i + 32 * F.wave + r;
        const bf16_t* V = P + 1664 + 128 * c;
        f32x16 o2[4]; float m, l; bf16x8 qf[4];
        LAS unsigned* o1s = (LAS unsigned*)(F.lds + 49152) + F.wave * 2048 + F.lane;
        att::load_q(qf, P + (size_t)qrow * CD_N + 128 * c, h);
        att::attn_pass<128, false, false>(F.lds, qf, P + 1024 + 128 * c, CD_N, V, CD_N, b * CTXL, 4, NCTX + b * SEQ, 64, 0, 0, o2, m, l, F.tid, F.lane);
        { const float inv = 1.0f / l;
#pragma unroll
            for (int cc = 0; cc < 4; ++cc)
#pragma unroll
                for (int k = 0; k < 8; ++k) o1s[(cc * 8 + k) * 64] = cvt_pk_bf16(o2[cc][2 * k] * inv, o2[cc][2 * k + 1] * inv); }
        att::load_q(qf, P + (size_t)qrow * CD_N + 128 * c + 64, h);
        att::attn_pass<128, false, false>(F.lds, qf, P + 1024 + 128 * c + 64, CD_N, V, CD_N, b * CTXL, 4, NCTX + b * SEQ, 64, 0, 0, o2, m, l, F.tid, F.lane);
        { const float inv = lam / l; float ss = 0.f;
#pragma unroll
            for (int cc = 0; cc < 4; ++cc)
#pragma unroll
                for (int k = 0; k < 8; ++k) { const unsigned w = o1s[(cc * 8 + k) * 64];
                    const float v0 = bf2f(w & 0xffffu) - inv * o2[cc][2 * k], v1 = bf2f(w >> 16) - inv * o2[cc][2 * k + 1]; o2[cc][2 * k] = v0; o2[cc][2 * k + 1] = v1; ss += v0 * v0 + v1 * v1; }
            { float sa = ss, sb = ss; swap32(sa, sb); ss = sa + sb; }
            const float rs = (1.0f - LAMBDA_INIT1) / sqrtf(ss * (1.0f / 128.0f) + RMS_EPS);
            const float* sg = A.in(13);
            bf16_t* Orow = O + (size_t)qrow * D + 128 * c;
#pragma unroll
            for (int cc = 0; cc < 4; ++cc)
#pragma unroll
                for (int g = 0; g < 4; g += 2) { const int dv = 32 * cc + 8 * g + 4 * h; const f32x4 g0 = *(const f32x4*)(sg + dv), g1 = *(const f32x4*)(sg + dv + 8);
                    att::store_pair(Orow, 32 * cc + 8 * g, (f32x4){o2[cc][4 * g] * rs * g0[0], o2[cc][4 * g + 1] * rs * g0[1], o2[cc][4 * g + 2] * rs * g0[2], o2[cc][4 * g + 3] * rs * g0[3]},
                                    (f32x4){o2[cc][4 * g + 4] * rs * g1[0], o2[cc][4 * g + 5] * rs * g1[1], o2[cc][4 * g + 6] * rs * g1[2], o2[cc][4 * g + 7] * rs * g1[3]}, h); }
        }
    }
    for (int rep_ = 0; rep_ < (ATTN_PROBE == 1 ? 2 : 1); ++rep_)
    for (int u = F.vcu; u < NU_D; u += F.G) {
        const int i = u & 15, qh = (u >> 4) & 7, b = u >> 7, kvh = qh >> 2;
        const int qrow = NCTX + b * SEQ + 256 * i + 32 * F.wave + r;
        f32x16 o[2]; float m, l; bf16x8 qf[4];
        att::load_q(qf, P + (size_t)qrow * CD_N + 512 + 64 * qh, h);
        att::attn_pass<64, false, true, 128>(F.lds, qf, P + 1536 + 64 * kvh, CD_N, P + 2176 + 64 * kvh, CD_N, b * CTXL, 4, NCTX + b * SEQ, 64, 0, 0, o, m, l, F.tid, F.lane);
        att::store_o<64>(o, 1.0f / l, O + (size_t)qrow * D + 512 + 64 * qh, h);
    }
}

__device__ __forceinline__ XcdBarrier frame_barrier(const Frame& F) { XcdBarrier b; b.bar = (unsigned*)(F.ws + WS_CTL) + CW_BAR; b.x = xb_xcc_id(); b.st = (volatile LAS unsigned*)(F.lds + MISC_OFF) + 8; return b; }
template <int L> __device__ __forceinline__ void p_rows1(Frame& F, const KArgs& A, int cw_off = 0, bool seam_wait = false) {
    const int row_lo = L == 0 ? 0 : NCTX;
    const int gw = F.vcu * 8 + F.wave, NGW = F.G * 8;
    LAS float* wt = (LAS float*)F.lds;
    LAS int* cntB = (LAS int*)(F.lds + LTAB_OFF);
    LAS int* baseB = cntB + 32;
    LAS int* lst = cntB + 64;
    { const float* rw = A.in(17) + (size_t)L * D * NE;
      const int e = F.tid & 31, dq = F.tid >> 5;
#pragma unroll 4
      for (int it = 0; it < 16; ++it) { const int d4 = dq + 16 * it; f32x4 w;
#pragma unroll
          for (int c = 0; c < 4; ++c) w[c] = rw[(size_t)(4 * d4 + c) * NE + e];
          *((LAS f32x4*)(wt + e * D) + (d4 ^ (e & 15))) = w; }
      if (F.tid < 32) cntB[F.tid] = 0; }
    if (seam_wait) { const XcdBarrier b_ = frame_barrier(F); xcd_wait(b_); } else __syncthreads();
    const float* modv = WSP(float, WS_MODV) + (size_t)L * 5 * NMOD;
    const bf16_t* Y = WSP(bf16_t, WS_Y); bf16_t* X1 = WSP(bf16_t, WS_X1); unsigned char* H8 = WSP(unsigned char, WS_H);
    const float* lng = A.in(6) + (size_t)(L * 2 + 0) * D; const float* lnb = A.in(7) + (size_t)(L * 2 + 0) * D;
    const float rbl = (A.in(18) + L * NE)[F.lane >> 1];
    int* tope = WSP(int, WS_TOPE); float* gate = WSP(float, WS_GATE); int* posb = WSP(int, WS_POS);
    int it = 0;
    f32x4 xn[2][4]; u32x2 xq[2][4], yn[2][4];
#define RW_FETCH(ROW0) do { _Pragma("unroll") for (int r = 0; r < 2; ++r) { const int row_ = (r == 0 || (ROW0) + NGW < NROW) ? (ROW0) + r * NGW : (ROW0); \
        if constexpr (L == 0) ld_row(xn[r], x_in_row(A, row_), F.lane); else { _Pragma("unroll") for (int j = 0; j < 4; ++j) xq[r][j] = *((const u32x2*)(WSP(bf16_t, WS_XR) + (size_t)row_ * D) + F.lane + 64 * j); } \
        _Pragma("unroll") for (int j = 0; j < 4; ++j) yn[r][j] = *((const u32x2*)(Y + (size_t)row_ * D) + F.lane + 64 * j); } } while (0)
    if (row_lo + gw < NROW) RW_FETCH(row_lo + gw);
    for (int row0 = row_lo + gw; row0 < NROW; row0 += 2 * NGW, it += 2) {
        const bool has2 = row0 + NGW < NROW;
        const int rows[2] = {row0, has2 ? row0 + NGW : row0};
        f32x4 v[2][4];
        { f32x4 g1[2][4];
#pragma unroll
          for (int r = 0; r < 2; ++r) { const float* mv = modv + (size_t)row_bi(rows[r]) * NMOD; ld_row(g1[r], mv + 2 * D, F.lane); }
#pragma unroll
          for (int r = 0; r < 2; ++r)
#pragma unroll
              for (int j = 0; j < 4; ++j) { const u32x2 w = yn[r][j]; f32x4 xv; if constexpr (L == 0) xv = xn[r][j]; else { const u32x2 q = xq[r][j]; xv = (f32x4){bf2f(q.x & 0xffffu), bf2f(q.x >> 16), bf2f(q.y & 0xffffu), bf2f(q.y >> 16)}; }
                  v[r][j] = DN_ALPHA * xv + g1[r][j] * (f32x4){bf2f(w.x & 0xffffu), bf2f(w.x >> 16), bf2f(w.y & 0xffffu), bf2f(w.y >> 16)}; } }
        { float s[2], s2[2];
#pragma unroll
          for (int r = 0; r < 2; ++r) { s[r] = 0.f;
#pragma unroll
              for (int j = 0; j < 4; ++j) s[r] += (v[r][j][0] + v[r][j][1]) + (v[r][j][2] + v[r][j][3]); }
#pragma unroll
          for (int r = 0; r < 2; ++r) s[r] = wave_sum(s[r]) * (1.0f / D);
#pragma unroll
          for (int r = 0; r < 2; ++r) { s2[r] = 0.f;
#pragma unroll
              for (int j = 0; j < 4; ++j) { v[r][j] = v[r][j] - s[r]; s2[r] += (v[r][j][0] * v[r][j][0] + v[r][j][1] * v[r][j][1]) + (v[r][j][2] * v[r][j][2] + v[r][j][3] * v[r][j][3]); } }
#pragma unroll
          for (int r = 0; r < 2; ++r) s2[r] = 1.0f / sqrtf(wave_sum(s2[r]) * (1.0f / D) + LN_EPS);
          f32x4 lg[4], lb[4]; ld_row(lg, lng, F.lane); ld_row(lb, lnb, F.lane);
#pragma unroll
          for (int r = 0; r < 2; ++r)
#pragma unroll
              for (int j = 0; j < 4; ++j) v[r][j] = v[r][j] * s2[r] * lg[j] + lb[j]; }
#pragma unroll
        for (int r = 0; r < 2; ++r) { const int row = rows[r]; const float* mv = modv + (size_t)row_bi(row) * NMOD;
            if (r == 0 || has2) st_row_bf16(X1 + (size_t)row * D, v[r], F.lane);
            f32x4 sh[4], sc[4]; ld_row(sh, mv + 3 * D, F.lane); ld_row(sc, mv + 4 * D, F.lane);
#pragma unroll
            for (int j = 0; j < 4; ++j) v[r][j] = v[r][j] * (1.0f + sc[j]) + sh[j];
            if (r == 0 || has2) st_row_fp8(H8 + (size_t)row * D, v[r], F.lane); }
        if (row0 + 2 * NGW < NROW) RW_FETCH(row0 + 2 * NGW);
        float part[2][8];
        {
#define RW_READ(W, G) do { _Pragma("unroll") for (int ee = 0; ee < 2; ++ee) { const int k_ = 2 * (G) + ee, E_ = ((k_ & 1) << 4) | ((k_ & 2) << 2) | (k_ & 4) | ((k_ & 8) >> 2) | ((k_ & 16) >> 4); \
            _Pragma("unroll") for (int j = 0; j < 4; ++j) W[ee * 4 + j] = *((const LAS f32x4*)(wt + E_ * D) + ((F.lane ^ (E_ & 15)) + 64 * j)); } } while (0)
          f32x4 wa[8], wb[8]; float l1prev[2] = {0.f, 0.f};
          RW_READ(wa, 0);
#pragma unroll
          for (int g = 0; g < 16; ++g) {
              if (g + 1 < 16) { if (g & 1) RW_READ(wa, g + 1); else RW_READ(wb, g + 1); }
              __builtin_amdgcn_sched_barrier(0);
              float pk[2][2];
#pragma unroll
              for (int ee = 0; ee < 2; ++ee) { f32x2 s0 = (f32x2){0.f, 0.f}, s1 = (f32x2){0.f, 0.f};
#pragma unroll
                  for (int j = 0; j < 4; ++j) { const f32x4 w = (g & 1) ? wb[ee * 4 + j] : wa[ee * 4 + j];
                      s0 = (f32x2){w[0], w[1]} * (f32x2){v[0][j][0], v[0][j][1]} + s0; s0 = (f32x2){w[2], w[3]} * (f32x2){v[0][j][2], v[0][j][3]} + s0;
                      s1 = (f32x2){w[0], w[1]} * (f32x2){v[1][j][0], v[1][j][1]} + s1; s1 = (f32x2){w[2], w[3]} * (f32x2){v[1][j][2], v[1][j][3]} + s1; }
                  pk[0][ee] = s0.x + s0.y; pk[1][ee] = s1.x + s1.y; }
#pragma unroll
              for (int r = 0; r < 2; ++r) { float a = pk[r][0], b2 = pk[r][1]; swap32(a, b2); const float l1 = a + b2;
                  if (g & 1) { float c = l1prev[r], d2 = l1; swap16(c, d2); part[r][g >> 1] = c + d2; } else l1prev[r] = l1; }
              __builtin_amdgcn_sched_barrier(0);
          }
#undef RW_READ
        }
#pragma unroll
        for (int r = 0; r < 2; ++r) { float (&pt)[8] = part[r];
            { const bool up = (F.lane >> 3) & 1;
#pragma unroll
              for (int i = 0; i < 4; ++i) { const float a = pt[2 * i], b2 = pt[2 * i + 1]; pt[i] = (up ? b2 : a) + dppf<DPP_XOR8>(up ? a : b2); } }
            { const bool up = (F.lane >> 2) & 1;
#pragma unroll
              for (int i = 0; i < 2; ++i) { const float a = pt[2 * i], b2 = pt[2 * i + 1]; pt[i] = (up ? b2 : a) + dppf<DPP_XOR7>(dppf<DPP_XOR3>(up ? a : b2)); } }
            { const bool up = (F.lane >> 1) & 1; const float a = pt[0], b2 = pt[1]; pt[0] = (up ? b2 : a) + dppf<DPP_XOR2>(up ? a : b2); } }
#pragma unroll
        for (int r = 0; r < 2; ++r) { const int row = rows[r];
            const float logit = part[r][0] + dppf<DPP_XOR1>(part[r][0]) + rbl;
            int key = __builtin_bit_cast(int, logit); key ^= (key >> 31) & 0x7fffffff;
            int te[4]; float tv[4];
#pragma unroll
            for (int k = 0; k < 4; ++k) { int m = key;
                m = max(m, dppi<DPP_XOR2>(m)); m = max(m, dppi<DPP_XOR7>(m)); m = max(m, dppi<DPP_XOR15>(m));
                { auto q = __builtin_amdgcn_permlane16_swap((unsigned)m, (unsigned)m, false, false); m = max((int)q[0], (int)q[1]); }
                { auto q = __builtin_amdgcn_permlane32_swap((unsigned)m, (unsigned)m, false, false); m = max((int)q[0], (int)q[1]); }
                const int e = (int)(__builtin_ctzll(__ballot(key == m)) >> 1);
                te[k] = e; tv[k] = __builtin_bit_cast(float, m ^ ((m >> 31) & 0x7fffffff)); if ((F.lane >> 1) == e) key = (int)0x80000000; }
            const float e1 = __expf(tv[1] - tv[0]), e2 = __expf(tv[2] - tv[0]), e3 = __expf(tv[3] - tv[0]); const float inv = 1.0f / (1.0f + e1 + e2 + e3);
            if (F.lane < 4 && (r == 0 || has2)) { const int k = F.lane; const int e = k == 0 ? te[0] : k == 1 ? te[1] : k == 2 ? te[2] : te[3]; const float gk = (k == 0 ? 1.0f : k == 1 ? e1 : k == 2 ? e2 : e3) * inv;
                tope[(size_t)row * 4 + k] = e; gate[(size_t)row * 4 + k] = gk;
                const int lp = __hip_atomic_fetch_add(cntB + e, 1, __ATOMIC_RELAXED, __HIP_MEMORY_SCOPE_WORKGROUP);
                lst[(F.wave * 12 + it + r) * 4 + k] = (e << 20) | lp; } }
    }
#undef RW_FETCH
    __syncthreads();
    if (F.tid < 32) baseB[F.tid] = (int)__hip_atomic_fetch_add((unsigned*)(F.ws + WS_CTL) + CW_CNT + 64 * L + cw_off + F.tid, (unsigned)cntB[F.tid], RLX_AGENT);
    __syncthreads();
    unsigned char* XGE = WSP(unsigned char, WS_XGE);
    it = 0;
    for (int row0 = row_lo + gw; row0 < NROW; row0 += 5 * NGW, it += 5) {
        u32x4 a[5]; int pos[5][4], ex[5][4];
#pragma unroll
        for (int r = 0; r < 5; ++r) { const int row = row0 + r * NGW;
            if (row < NROW) { a[r] = *((const u32x4*)(H8 + (size_t)row * D) + F.lane);
#pragma unroll
                for (int k = 0; k < 4; ++k) { const int pk = __builtin_amdgcn_readfirstlane(lst[(F.wave * 12 + it + r) * 4 + k]); ex[r][k] = pk >> 20; pos[r][k] = __builtin_amdgcn_readfirstlane(baseB[pk >> 20]) + (pk & 0xFFFFF); } } }
#pragma unroll
        for (int r = 0; r < 5; ++r) { const int row = row0 + r * NGW;
            if (row < NROW) {
#pragma unroll
                for (int k = 0; k < 4; ++k) *((u32x4*)(XGE + ((size_t)ex[r][k] * CAPR + pos[r][k]) * D) + F.lane) = a[r];
                if (F.lane < 4) posb[(size_t)row * 4 + F.lane] = F.lane == 0 ? pos[r][0] : F.lane == 1 ? pos[r][1] : F.lane == 2 ? pos[r][2] : pos[r][3]; } }
    }
}
__device__ __forceinline__ int expert_offsets(Frame& F, int L, int& cnt_out, int& total) {
    const int c = (int)__hip_atomic_load((unsigned*)(F.ws + WS_CTL) + CW_CNT + 64 * L + (F.lane & 31), RLX_AGENT);
    const int pad = (c + 255) & ~255; int incl = pad;
#pragma unroll
    for (int o = 1; o < 32; o <<= 1) { const int t = __shfl_up(incl, o); if ((F.lane & 31) >= o) incl += t; }
    total = __shfl(incl, 31); cnt_out = c; return incl - pad;
}
template <int L> __device__ __forceinline__ void p_gather(Frame& F, const KArgs& A) {
    const int row_lo = L == 0 ? 0 : NCTX;
    const int gw = F.vcu * 8 + F.wave, NGW = F.G * 8;
    int cnt, total; const int offs = expert_offsets(F, L, cnt, total);
    const unsigned char* H8 = WSP(unsigned char, WS_H); unsigned char* XG = WSP(unsigned char, WS_XG);
    const int* tope = WSP(int, WS_TOPE); const int* posb = WSP(int, WS_POS); int* slot = WSP(int, WS_SLOT);
    for (int row0 = row_lo + gw; row0 < NROW; row0 += 5 * NGW) {
        u32x4 a[5]; int sl[5][4];
#pragma unroll
        for (int r = 0; r < 5; ++r) { const int row = row0 + r * NGW;
            if (row < NROW) { a[r] = *((const u32x4*)(H8 + (size_t)row * D) + F.lane);
#pragma unroll
                for (int k = 0; k < 4; ++k) { const int e = __builtin_amdgcn_readfirstlane(tope[(size_t)row * 4 + k]); sl[r][k] = __builtin_amdgcn_readlane(offs, e) + __builtin_amdgcn_readfirstlane(posb[(size_t)row * 4 + k]); } } }
#pragma unroll
        for (int r = 0; r < 5; ++r) { const int row = row0 + r * NGW;
            if (row < NROW) {
#pragma unroll
                for (int k = 0; k < 4; ++k) *((u32x4*)(XG + (size_t)sl[r][k] * D) + F.lane) = a[r];
                if (F.lane < 4) slot[(size_t)row * 4 + F.lane] = F.lane == 0 ? sl[r][0] : F.lane == 1 ? sl[r][1] : F.lane == 2 ? sl[r][2] : sl[r][3]; } }
    }
    if (gw < 256) { const int e = gw >> 3; const int o = __shfl(offs, e), c = __shfl(cnt, e); const int pad = (c + 255) & ~255;
        for (int rr = o + c + (gw & 7); rr < o + pad; rr += 8) *((u32x4*)(XG + (size_t)rr * D) + F.lane) = (u32x4){0u, 0u, 0u, 0u}; }
}
__device__ __forceinline__ void build_tile_table(Frame& F, int L, LAS int* tile_e) {
    int cnt, total; const int offs = expert_offsets(F, L, cnt, total);
    if (F.wave == 0 && F.lane < 32) { const int t0 = offs >> 8, n = ((cnt + 255) & ~255) >> 8; for (int t = 0; t < n; ++t) tile_e[t0 + t] = F.lane; tile_e[320 + F.lane] = t0; if (F.lane == 0) tile_e[320 + 32] = total >> 8; }
    __syncthreads();
}
__device__ __forceinline__ MoeOrder moe_order(Frame& F, const LAS int* tile_e, int nN, const void* A, size_t a_tile, const void* B, size_t b_tile, size_t b_exp, int a_cap = 0) {
    MoeOrder S; (void)0;
    S.nN = nN; S.per = F.G; S.j = F.vcu; S.tile_e = tile_e; S.A = (const char*)A; S.B = (const char*)B; S.a_tile = a_tile; S.b_tile = b_tile; S.b_exp = b_exp;
    S.T0 = 0; S.T1 = __builtin_amdgcn_readfirstlane(tile_e[320 + 32]); S.a_cap = a_cap;
    return S;
}
template <int L> __device__ __forceinline__ void p_rows2(Frame& F, const KArgs& A) {
    const int row_lo = L == 0 ? 0 : NCTX;
    const int gw = F.vcu * 8 + F.wave, NGW = F.G * 8;
    const float* modv = WSP(float, WS_MODV) + (size_t)L * 5 * NMOD;
    const bf16_t* X1 = WSP(bf16_t, WS_X1); const unsigned char* YB = WSP(unsigned char, WS_XG);
    const float* lng = A.in(6) + (size_t)(L * 2 + 1) * D; const float* lnb = A.in(7) + (size_t)(L * 2 + 1) * D;
    const int* tope = WSP(int, WS_TOPE); const int* posb = WSP(int, WS_POS); const float* gate = WSP(float, WS_GATE);
    int cnt_, total_; const int offs = expert_offsets(F, L, cnt_, total_);
    for (int row = row_lo + gw; row < NROW; row += NGW) {
        const float* mv = modv + (size_t)row_bi(row) * NMOD;
        f32x4 f[4];
#pragma unroll
        for (int j = 0; j < 4; ++j) f[j] = (f32x4){0.f, 0.f, 0.f, 0.f};
#pragma unroll
        for (int k = 0; k < 4; ++k) { const int sl = __builtin_amdgcn_readlane(offs, __builtin_amdgcn_readfirstlane(tope[(size_t)row * 4 + k])) + __builtin_amdgcn_readfirstlane(posb[(size_t)row * 4 + k]); const float gk = gate[(size_t)row * 4 + k];
#pragma unroll
            for (int j = 0; j < 4; ++j) { const unsigned w = *((const unsigned*)(YB + (size_t)sl * D) + F.lane + 64 * j);
                const f32x2 lo = __builtin_amdgcn_cvt_pk_f32_fp8(w, false) * gk + (f32x2){f[j][0], f[j][1]}, hi = __builtin_amdgcn_cvt_pk_f32_fp8(w, true) * gk + (f32x2){f[j][2], f[j][3]};
                f[j] = (f32x4){lo.x, lo.y, hi.x, hi.y}; } }
        f32x4 v[4], g2[4]; ld_row_bf16(v, X1 + (size_t)row * D, F.lane); ld_row(g2, mv + 5 * D, F.lane);
#pragma unroll
        for (int j = 0; j < 4; ++j) v[j] = DN_ALPHA * v[j] + g2[j] * f[j];
        layernorm_row(v, lng, lnb, F.lane);
        if (L == 0) {
            st_row_bf16(WSP(bf16_t, WS_XR) + (size_t)row * D, v, F.lane);
            const float* mv1 = WSP(float, WS_MODV) + (size_t)(5 + row_bi(row)) * NMOD;
            f32x4 sh[4], sc[4]; ld_row(sh, mv1, F.lane); ld_row(sc, mv1 + D, F.lane);
#pragma unroll
            for (int j = 0; j < 4; ++j) v[j] = v[j] * (1.0f + sc[j]) + sh[j];
            st_row_bf16(WSP(bf16_t, WS_H) + (size_t)row * D, v, F.lane);
        } else {
            st_row((float*)A.in(23) + (size_t)(row - NCTX) * D, v, F.lane);
        }
    }
}

constexpr int NPHASE = 19;
__global__ void __launch_bounds__(512, 2) mk_fwd(Args args) {
    extern __shared__ __attribute__((aligned(16))) unsigned char lds_raw[];
    Frame F;
    KArgs KA; KA.p = (const __attribute__((address_space(4))) unsigned char*)__builtin_amdgcn_kernarg_segment_ptr();
    F.lds = (ldsp_t)lds_raw;
    F.tid = threadIdx.x; F.lane = F.tid & 63; F.wave = __builtin_amdgcn_readfirstlane(F.tid >> 6);
    F.G = gridDim.x; { const int bx = blockIdx.x; F.vcu = (F.G % 8 == 0) ? (bx % 8) * (F.G / 8) + bx / 8 : bx; }
    F.ws = args.ws;
    for (int u = F.tid; u < (LDS_BYTES - LDSCTL_OFF) / 4; u += 512) ((LAS unsigned*)(F.lds + LDSCTL_OFF))[u] = 0u;
    __syncthreads();
    if (MK_MODE == 1) (void)xcd_barrier_post((unsigned*)(F.ws + WS_CTL) + CW_BAR, (volatile LAS unsigned*)(F.lds + MISC_OFF) + 8);
    const int lo = args.ph_lo, hi = args.ph_hi;
#ifndef PH_MASK
#define PH_MASK 0x7FFFF
#endif
#define IN(k) ((((PH_MASK) >> (k)) & 1) && lo <= (k) && (k) < hi)
#ifndef PROBE_SEAM
#define PROBE_SEAM 0
#endif
#define SEAM(k) do { if (IN(k) && IN((k) + 1)) { const XcdBarrier b_ = frame_barrier(F); xcd_barrier(b_); if (PROBE_SEAM) xcd_barrier(b_); } } while (0)
#define ARRIVE(k) do { if (IN(k) && IN((k) + 1)) { const XcdBarrier b_ = frame_barrier(F); xcd_arrive(b_); } } while (0)
#define WAIT(k) do { if (IN(k) && IN((k) + 1)) { const XcdBarrier b_ = frame_barrier(F); xcd_wait(b_); if (PROBE_SEAM) xcd_barrier(b_); } } while (0)
#ifndef PH_REPEAT
#define PH_REPEAT 0
#endif
#define REPBIT(k) (((PH_REPEAT) >> (k)) & 1)
#define FRESH_IDS() do { int l_ = lane_id(); asm volatile("" : "+v"(l_)); F.lane = l_; F.tid = F.wave * 64 + l_; } while (0)
#define PHASE(k, ...) do { if (IN(k)) { FRESH_IDS(); { __VA_ARGS__ } if (REPBIT(k)) { __VA_ARGS__ } } } while (0)

    PHASE(0,  p0_prologue(F, KA); ); SEAM(0);
    PHASE(1,  p_modulate0(F, KA); ); SEAM(1);
    PHASE(2,
        { pg8::Gemm g{D / 64, 2048u, 2048u}; GridOrder S; S.init(68, 5, F.G, F.vcu, 0, WSP(char, WS_H), 256u * 2048u, WSP(char, WS_WABI), 256u * 2048u);
          EpiIn0 E{WSP(bf16_t, WS_PB), WSP(float, WS_ROPE), WSP(float, WS_ROPE) + 1024};
          pg8::gemm_phase<EpiIn0, GridOrder, PG8_ALIGN, PG8_SP2>(F.lds, g, S, E, F.wave); }
        { pg8::Gemm g{D / 64, 2048u, 2048u}; GridOrder S; S.init(2, 68, F.G, F.vcu, 84, WSP(char, WS_WF), 256u * 2048u, WSP(char, WS_H), 256u * 2048u);
          EpiGT E{WSP(bf16_t, WS_GT), WSP(bf16_t, WS_GTC)};
          pg8::gemm_phase<EpiGT, GridOrder, PG8_ALIGN, PG8_SP2>(F.lds, g, S, E, F.wave); }
        if (F.G == 256 && F.vcu >= 220) bg_range(F, KA, BG_P2, 220, 3);
    ); SEAM(2);
    PHASE(3,  p_fourier1(F); ); ARRIVE(3);
    PHASE(4,
        p_attn0(F, KA);
        WAIT(3);
        { pg8::Gemm g{512 / 64, 1024u, 1024u}; FourierOrder S{F.G, (F.vcu + F.G - 48) % F.G, WSP(char, WS_ADFT), WSP(char, WS_YF), WSP(char, WS_GTC)};
          EpiFour E{WSP(bf16_t, WS_O)};
          pg8::gemm_phase<EpiFour, FourierOrder, PG8_ALIGN, PG8_SP2>(F.lds, g, S, E, F.wave); }
    ); SEAM(4);
    PHASE(5,
        pg8::Gemm g{D / 64, 2048u, 2048u}; GridOrder S; S.init(68, 4, F.G, F.vcu, 0, WSP(char, WS_O), 256u * 2048u, WSP(char, WS_WABO), 256u * 2048u);
        EpiY E{WSP(bf16_t, WS_Y), D};
        pg8::gemm_phase<EpiY, GridOrder, PG8_ALIGN, PG8_SP2>(F.lds, g, S, E, F.wave);
        if (F.G == 256 && F.vcu >= 16) bg_range(F, KA, BG_P5, 16, 2);
    ); ARRIVE(5);
#ifndef PROBE_ROWS1
#define PROBE_ROWS1 0
#endif
    PHASE(6,  p_rows1<0>(F, KA, 0, IN(5) && IN(6)); if (PROBE_ROWS1 == 1) p_rows1<0>(F, KA, 32); ); SEAM(6);
    PHASE(8,
        LAS int* tile_e = (LAS int*)(F.lds + LTAB_OFF); build_tile_table(F, 0, tile_e);
        pg8::Gemm g{D / 128, 1024u, 1024u};
        const MoeOrder S = moe_order(F, tile_e, 8, WSP(char, WS_XGE), 256u * 1024u, WSP(char, WS_WGU) + (size_t)0 * 32 * 2048 * D, 256u * 1024u, (size_t)2048 * D, CAPR / 256);
        EpiSwiglu E{WSP(unsigned char, WS_ACT), KA.in(20) + (size_t)0 * 32 * 2048};
        pg8::gemm_phase<EpiSwiglu, MoeOrder, PG8_ALIGN, PG8_SP2, true>(F.lds, g, S, E, F.wave);
        if (F.G == 256) { const int r9 = bg_moe_idle(S.T1, 4, 256), r8 = bg_moe_idle(S.T1, 8, 256); if (r8 != 0 && F.vcu >= r8) bg_range(F, KA, BG_P9 + (r9 ? (256 - r9) * 8 : 0), r8, 1); }
    ); SEAM(8);
    PHASE(9,
        LAS int* tile_e = (LAS int*)(F.lds + LTAB_OFF); if (!IN(8)) build_tile_table(F, 0, tile_e);
        pg8::Gemm g{FF / 128, 128u, 1024u, 256u * 128u, 128u};
        const MoeOrder S = moe_order(F, tile_e, 4, WSP(char, WS_ACT), 256u * 1024u, WSP(char, WS_WD) + (size_t)0 * 32 * D * FF, 256u * 1024u, (size_t)D * FF);
        EpiDown E{WSP(unsigned char, WS_XG), KA.in(22) + (size_t)0 * 32 * D};
        pg8::gemm_phase<EpiDown, MoeOrder, PG8_ALIGN, PG8_SP2, true>(F.lds, g, S, E, F.wave);
        if (F.G == 256) { const int r9 = bg_moe_idle(S.T1, 4, 256); if (r9 != 0 && F.vcu >= r9) bg_range(F, KA, BG_P9, r9, 1); }
    ); SEAM(9);
    PHASE(10,  p_rows2<0>(F, KA); ); SEAM(10);
    PHASE(11,
        pg8::Gemm g{D / 64, 2048u, 2048u}; GridOrder S; S.init(68, 9, F.G, F.vcu, 0, WSP(char, WS_H), 256u * 2048u, WSP(char, WS_WCDI), 256u * 2048u);
        EpiIn1 E{WSP(bf16_t, WS_PB), WSP(float, WS_ROPE), WSP(float, WS_ROPE) + 1024, KA.in(14), KA.in(15)};
        pg8::gemm_phase<EpiIn1, GridOrder, PG8_ALIGN, PG8_SP2>(F.lds, g, S, E, F.wave);
        if (F.G == 256 && F.vcu >= 100) bg_range(F, KA, BG_P11, 100, 3);
    ); SEAM(11);
    PHASE(12,  p_attn1(F, KA); ); SEAM(12);
    PHASE(13,
        pg8::Gemm g{D / 64, 2048u, 2048u}; GridOrder S; S.init(64, 4, F.G, F.vcu, 0, WSP(char, WS_O) + (size_t)NCTX * 2048u, 256u * 2048u, WSP(char, WS_WCDO), 256u * 2048u);
        EpiY E{WSP(bf16_t, WS_Y) + (size_t)NCTX * D, D};
        pg8::gemm_phase<EpiY, GridOrder, PG8_ALIGN, PG8_SP2>(F.lds, g, S, E, F.wave);
    ); ARRIVE(13);
    PHASE(14,  p_rows1<1>(F, KA, 0, IN(13) && IN(14)); if (PROBE_ROWS1 == 2) p_rows1<1>(F, KA, 32); __syncthreads();
        { int cnt_, total_; (void)expert_offsets(F, 0, cnt_, total_); const int T1 = __builtin_amdgcn_readfirstlane(total_) >> 8;
          int start = 0;
          if (F.G == 256) { const int r9 = bg_moe_idle(T1, 4, 256), r8 = bg_moe_idle(T1, 8, 256); start = BG_P9 + (r9 ? (256 - r9) * 8 : 0) + (r8 ? (256 - r8) * 8 : 0); }
          const int stop = BG_TOTAL - (F.G == 256 ? BG_HOLD : 0);
          for (int s = start + F.vcu * 8 + F.wave; s < stop; s += F.G * 8) bg_step(F, KA, s); }
    ); SEAM(14);
    PHASE(16,
        LAS int* tile_e = (LAS int*)(F.lds + LTAB_OFF); build_tile_table(F, 1, tile_e);
        pg8::Gemm g{D / 128, 1024u, 1024u};
        const MoeOrder S = moe_order(F, tile_e, 8, WSP(char, WS_XGE), 256u * 1024u, WSP(char, WS_WGU) + (size_t)1 * 32 * 2048 * D, 256u * 1024u, (size_t)2048 * D, CAPR / 256);
        EpiSwiglu E{WSP(unsigned char, WS_ACT), KA.in(20) + (size_t)1 * 32 * 2048};
        pg8::gemm_phase<EpiSwiglu, MoeOrder, PG8_ALIGN, PG8_SP2, true>(F.lds, g, S, E, F.wave);
        if (F.G == 256) { const int r16 = bg_moe_idle(S.T1, 8, 256); const int first = (r16 != 0 && 256 - r16 >= 64) ? r16 : 0;
            const int per = (BG_HOLD + (256 - first) * 8 - 1) / ((256 - first) * 8);
            if (F.vcu >= first) bg_range(F, KA, BG_TOTAL - BG_HOLD, first, per); }
    ); SEAM(16);
    PHASE(17,
        LAS int* tile_e = (LAS int*)(F.lds + LTAB_OFF); if (!IN(16)) build_tile_table(F, 1, tile_e);
        pg8::Gemm g{FF / 128, 128u, 1024u, 256u * 128u, 128u};
        const MoeOrder S = moe_order(F, tile_e, 4, WSP(char, WS_ACT), 256u * 1024u, WSP(char, WS_WD) + (size_t)1 * 32 * D * FF, 256u * 1024u, (size_t)D * FF);
        EpiDown E{WSP(unsigned char, WS_XG), KA.in(22) + (size_t)1 * 32 * D};
        pg8::gemm_phase<EpiDown, MoeOrder, PG8_ALIGN, PG8_SP2, true>(F.lds, g, S, E, F.wave);
    ); SEAM(17);
    PHASE(18,  p_rows2<1>(F, KA); );
#undef IN
#undef SEAM
}

extern "C" void kernel_launch(void* const* d_in, const int* in_sizes, int n_in, void* d_out, int out_size, void* d_ws, size_t ws_size, hipStream_t stream) {
    static int grid = 0;
    if (grid == 0) {
        if (n_in != 23 || out_size != NLAT * D || ws_size < WS_END) { fprintf(stderr, "kernel_launch: unexpected shapes (n_in %d, out %d, ws %zu)\n", n_in, out_size, ws_size); grid = -1; return; }
        int dev = 0, cus = 0, per_cu = 0;
        if (hipGetDevice(&dev) != hipSuccess || hipDeviceGetAttribute(&cus, hipDeviceAttributeMultiprocessorCount, dev) != hipSuccess) { grid = -1; return; }
        if (hipFuncSetAttribute((const void*)mk_fwd, hipFuncAttributeMaxDynamicSharedMemorySize, LDS_BYTES) != hipSuccess) { fprintf(stderr, "kernel_launch: hipFuncSetAttribute failed\n"); grid = -1; return; }
        if (hipOccupancyMaxActiveBlocksPerMultiprocessor(&per_cu, (const void*)mk_fwd, 512, LDS_BYTES) != hipSuccess || per_cu < 1) { fprintf(stderr, "kernel_launch: occupancy query reports %d\n", per_cu); }
        (void)hipGetLastError();
        grid = cus;
    }
    if (grid < 0) return;
    if (hipMemsetAsync((char*)d_ws + WS_CTL, 0, CTL_ZERO_BYTES, stream) != hipSuccess) return;
    Args a{};
    for (int i = 0; i < 23; ++i) a.in[i] = (const float*)d_in[i];
    a.out = (float*)d_out; a.ws = (unsigned char*)d_ws;
#if MK_MODE == 1
    a.ph_lo = 0; a.ph_hi = NPHASE;
    hipLaunchKernelGGL(mk_fwd, dim3(grid), dim3(512), LDS_BYTES, stream, a);
#else
#ifndef PROBE_PHASE
#define PROBE_PHASE -1
#endif
    for (int p = 0; p < NPHASE; ++p) { a.ph_lo = p; a.ph_hi = p + 1; for (int r = 0; r < (p == PROBE_PHASE ? 2 : 1); ++r) hipLaunchKernelGGL(mk_fwd, dim3(grid), dim3(512), LDS_BYTES, stream, a); }
#endif
}
```
